# Optimizing an MI355X kernel written in HIP

```python
import jax, jax.numpy as jnp
from jax import lax
import numpy as np


D_MODEL = 1024
BATCH = 8
SEQ = 8192
DEPTH = 2

PLE_DIM = 256
D_FF = 2816
EPS = 1e-6
ROPE_THETA = 10000.0
RET_THETA = 10000.0
N_NORMS = 7

A_HEADS = 4
A_DK = 128
A_DV = 128
A_CHUNK = 64
B_Q_HEADS = 8
B_KV_HEADS = 2
B_HEAD_DIM = 64
B_WINDOW = 128
B_BLOCK = 128
C_HEADS = 4
C_DK = 256
C_DV = 512
C_CHUNK = 128

N_EVEN = (DEPTH + 1) // 2
N_ODD = DEPTH // 2

A_KW = A_HEADS * A_DK
A_VW = A_HEADS * A_DV
B_QW = B_Q_HEADS * B_HEAD_DIM
B_KW = B_KV_HEADS * B_HEAD_DIM
EVEN_SPLITS = [A_KW, 2 * A_KW, 2 * A_KW + A_VW, 2 * A_KW + 2 * A_VW, 2 * A_KW + 2 * A_VW + B_QW,
               2 * A_KW + 2 * A_VW + B_QW + B_KW]
EVEN_IN = 2 * A_KW + 2 * A_VW + B_QW + 2 * B_KW
EVEN_OUT = A_VW + B_QW
C_KW = C_HEADS * C_DK
C_VW = C_HEADS * C_DV
ODD_SPLITS = [C_KW, 2 * C_KW, 2 * C_KW + C_VW]
ODD_IN = 2 * C_KW + 2 * C_VW
ODD_OUT = C_VW

kernel_name = 'hybrid_hgrn2_swa_sink_retention_macaron'


def rmsnorm(x, g):
    xf = x.astype(jnp.float32)
    y = xf * lax.rsqrt(jnp.mean(xf * xf, axis=-1, keepdims=True) + EPS)
    return (y * g.astype(jnp.float32)).astype(x.dtype)


def swiglu(x, w_in, w_out):
    gate, up = jnp.split(x @ w_in, 2, axis=-1)
    return (jax.nn.silu(gate) * up) @ w_out


def rope_tables(positions, inv_freq):
    ang = positions.astype(jnp.float32)[:, :, None] * inv_freq[None, None, :]
    return jnp.cos(ang)[:, :, None, :], jnp.sin(ang)[:, :, None, :]


def apply_rope(x, cos, sin):
    xf = x.astype(jnp.float32)
    x1, x2 = jnp.split(xf, 2, axis=-1)
    return jnp.concatenate([x1 * cos - x2 * sin, x2 * cos + x1 * sin], axis=-1).astype(x.dtype)


def hgrn2_chunkwise(q, f_logit, i, lb):
    B, S, H, K = q.shape
    V = i.shape[-1]
    C = A_CHUNK
    n = S // C

    def chunks(t):
        return t.astype(jnp.float32).reshape(B, n, C, H, -1).transpose(0, 3, 1, 2, 4)

    lb5 = lb[None, :, None, None, :]
    qf = jax.nn.silu(chunks(q))
    f = lb5 + (1.0 - lb5) * jax.nn.sigmoid(chunks(f_logit))
    k = 1.0 - f
    v = chunks(i)
    b = jnp.cumsum(jnp.log(f), axis=3)
    b_last = b[:, :, :, -1:, :]
    q_s = qf * jnp.exp(b)
    k_s = k * jnp.exp(-b)
    k_d = k * jnp.exp(b_last - b)
    causal = jnp.tril(jnp.ones((C, C), dtype=bool))
    att = jnp.where(causal, jnp.einsum('bhnck,bhnsk->bhncs', q_s, k_s), 0.0)
    intra = jnp.einsum('bhncs,bhnsv->bhncv', att, v)
    dec = jnp.exp(b_last[:, :, :, 0, :])

    def step(state, xs):
        qc, kc, vc, dc = xs
        o = jnp.einsum('bhck,bhkv->bhcv', qc, state)
        state = state * dc[..., None] + jnp.einsum('bhck,bhcv->bhkv', kc, vc)
        return state, o

    xs = (jnp.moveaxis(q_s, 2, 0), jnp.moveaxis(k_d, 2, 0), jnp.moveaxis(v, 2, 0), jnp.moveaxis(dec, 2, 0))
    _, inter = lax.scan(step, jnp.zeros((B, H, K, V), jnp.float32), xs)
    o = intra + jnp.moveaxis(inter, 0, 2)
    return o.transpose(0, 2, 3, 1, 4).reshape(B, S, H, V)


def swa_with_sinks(q, k, v, sinks):
    B, S, Hq, D = q.shape
    G = k.shape[2]
    R = Hq // G
    L = B_BLOCK
    nb = S // L
    qb = q.reshape(B, nb, L, G, R, D)
    kb = k.reshape(B, nb, L, G, D)
    vb = v.reshape(B, nb, L, G, D)
    pad = ((0, 0), (1, 0), (0, 0), (0, 0), (0, 0))
    kk = jnp.concatenate([jnp.pad(kb[:, :-1], pad), kb], axis=2)
    vv = jnp.concatenate([jnp.pad(vb[:, :-1], pad), vb], axis=2)
    s = jnp.einsum('bnqgrd,bnkgd->bngrqk', qb, kk).astype(jnp.float32) * (D ** -0.5)
    qi = jnp.arange(L)[:, None]
    kj = jnp.arange(2 * L)[None, :]
    diff = qi + L - kj
    band = (diff >= 0) & (diff < B_WINDOW)
    key_pos = jnp.arange(nb)[:, None, None] * L - L + kj[None]
    valid = band[None] & (key_pos >= 0)
    s = jnp.where(valid[None, :, None, None], s, -jnp.inf)
    sink = sinks.astype(jnp.float32).reshape(G, R)[None, None, :, :, None, None]
    m = jnp.maximum(jnp.max(s, axis=-1, keepdims=True), sink)
    pr = jnp.exp(s - m)
    denom = jnp.sum(pr, axis=-1, keepdims=True) + jnp.exp(sink - m)
    o = jnp.einsum('bngrqk,bnkgd->bnqgrd', (pr / denom).astype(vv.dtype), vv)
    return o.reshape(B, S, Hq * D)


def retention_chunkwise(q, k, v):
    B, S, H, K = q.shape
    V = v.shape[-1]
    C = C_CHUNK
    n = S // C
    lg = jnp.log1p(-jnp.exp2(-5.0 - jnp.arange(H, dtype=jnp.float32)))

    def chunks(t):
        return t.astype(jnp.float32).reshape(B, n, C, H, -1).transpose(0, 3, 1, 2, 4)

    qc = chunks(q)
    kc = chunks(k) * (K ** -0.5)
    vc = chunks(v)
    idx = jnp.arange(C, dtype=jnp.float32)
    diff = idx[:, None] - idx[None, :]
    decay = jnp.where(diff >= 0, jnp.exp(jnp.maximum(diff, 0.0)[None] * lg[:, None, None]), 0.0)
    att = jnp.einsum('bhnck,bhnsk->bhncs', qc, kc) * decay[None, :, None]
    intra = jnp.einsum('bhncs,bhnsv->bhncv', att, vc)
    q_in = qc * jnp.exp((idx + 1.0)[None, :] * lg[:, None])[None, :, None, :, None]
    k_in = kc * jnp.exp((C - 1.0 - idx)[None, :] * lg[:, None])[None, :, None, :, None]
    chunk_dec = jnp.exp(C * lg)[None, :, None, None]

    def step(state, xs):
        qx, kx, vx = xs
        o = jnp.einsum('bhck,bhkv->bhcv', qx, state)
        state = state * chunk_dec + jnp.einsum('bhck,bhcv->bhkv', kx, vx)
        return state, o

    xs = (jnp.moveaxis(q_in, 2, 0), jnp.moveaxis(k_in, 2, 0), jnp.moveaxis(vc, 2, 0))
    _, inter = lax.scan(step, jnp.zeros((B, H, K, V), jnp.float32), xs)
    o = intra + jnp.moveaxis(inter, 0, 2)
    return o.transpose(0, 2, 3, 1, 4).reshape(B, S, H, V)


def even_mixer(u, w_in, w_out, lb, onorm_g, sinks, cos_b, sin_b):
    B, S, _ = u.shape
    qa, fa, ia, ga, qb, kb, vb = jnp.split(u @ w_in, EVEN_SPLITS, axis=-1)
    oa = hgrn2_chunkwise(qa.reshape(B, S, A_HEADS, A_DK), fa.reshape(B, S, A_HEADS, A_DK),
                         ia.reshape(B, S, A_HEADS, A_DV), lb.reshape(A_HEADS, A_DK))
    oa = rmsnorm(oa, onorm_g) * jax.nn.silu(ga.reshape(B, S, A_HEADS, A_DV).astype(jnp.float32))
    oa = oa.reshape(B, S, A_VW).astype(u.dtype)
    qh = apply_rope(qb.reshape(B, S, B_Q_HEADS, B_HEAD_DIM), cos_b, sin_b)
    kh = apply_rope(kb.reshape(B, S, B_KV_HEADS, B_HEAD_DIM), cos_b, sin_b)
    ob = swa_with_sinks(qh, kh, vb.reshape(B, S, B_KV_HEADS, B_HEAD_DIM), sinks).astype(u.dtype)
    return jnp.concatenate([oa, ob], axis=-1) @ w_out


def odd_mixer(u, w_in, w_out, onorm_g, cos_c, sin_c):
    B, S, _ = u.shape
    qc, kc, vc, gc = jnp.split(u @ w_in, ODD_SPLITS, axis=-1)
    qh = apply_rope(qc.reshape(B, S, C_HEADS, C_DK), cos_c, sin_c)
    kh = apply_rope(kc.reshape(B, S, C_HEADS, C_DK), cos_c, sin_c)
    o = retention_chunkwise(qh, kh, vc.reshape(B, S, C_HEADS, C_DV))
    o = rmsnorm(o, onorm_g) * jax.nn.silu(gc.reshape(B, S, C_HEADS, C_DV).astype(jnp.float32))
    return o.reshape(B, S, C_VW).astype(u.dtype) @ w_out


def setup_inputs(seed: int = 0) -> dict:
    key = jax.random.key(seed)
    ks = jax.random.split(key, 18)
    f32 = jnp.float32

    def w(k, shape, fan_in):
        return jax.random.normal(k, shape, f32) * (fan_in ** -0.5)

    x = jax.random.normal(ks[0], (BATCH, SEQ, D_MODEL), f32)
    p = jax.random.normal(ks[1], (DEPTH, BATCH, SEQ, PLE_DIM), f32)
    offsets = jax.random.randint(ks[2], (BATCH, 1), 0, 4096, dtype=jnp.int32)
    positions = (offsets + jnp.arange(SEQ, dtype=jnp.int32)[None, :]).astype(jnp.int32)
    norm_g = 1.0 + 0.05 * jax.random.normal(ks[3], (DEPTH, N_NORMS, D_MODEL), f32)
    ffn1_w_in = w(ks[4], (DEPTH, D_MODEL, 2 * D_FF), D_MODEL)
    ffn1_w_out = w(ks[5], (DEPTH, D_FF, D_MODEL), D_FF)
    ffn2_w_in = w(ks[6], (DEPTH, D_MODEL, 2 * D_FF), D_MODEL)
    ffn2_w_out = w(ks[7], (DEPTH, D_FF, D_MODEL), D_FF)
    ple_w_proj = w(ks[8], (DEPTH, PLE_DIM, D_MODEL), PLE_DIM)
    ple_w_gate = w(ks[9], (DEPTH, D_MODEL, D_MODEL), D_MODEL)
    even_w_in = w(ks[10], (N_EVEN, D_MODEL, EVEN_IN), D_MODEL)
    even_w_out = w(ks[11], (N_EVEN, EVEN_OUT, D_MODEL), EVEN_OUT)
    hgrn_lb = 0.1 * jax.random.normal(ks[12], (N_EVEN + 1, A_KW), f32)
    hgrn_onorm_g = 1.0 + 0.05 * jax.random.normal(ks[13], (N_EVEN, A_DV), f32)
    attn_sinks = jax.random.normal(ks[14], (N_EVEN, B_Q_HEADS), f32)
    odd_w_in = w(ks[15], (N_ODD, D_MODEL, ODD_IN), D_MODEL)
    odd_w_out = w(ks[16], (N_ODD, ODD_OUT, D_MODEL), ODD_OUT)
    ret_onorm_g = 1.0 + 0.05 * jax.random.normal(ks[17], (N_ODD, C_DV), f32)
    return {'x': x, 'p': p, 'positions': positions, 'norm_g': norm_g,
            'ffn1_w_in': ffn1_w_in, 'ffn1_w_out': ffn1_w_out, 'ffn2_w_in': ffn2_w_in, 'ffn2_w_out': ffn2_w_out,
            'ple_w_proj': ple_w_proj, 'ple_w_gate': ple_w_gate,
            'even_w_in': even_w_in, 'even_w_out': even_w_out, 'hgrn_lb': hgrn_lb, 'hgrn_onorm_g': hgrn_onorm_g,
            'attn_sinks': attn_sinks, 'odd_w_in': odd_w_in, 'odd_w_out': odd_w_out, 'ret_onorm_g': ret_onorm_g}


def reference(x, p, positions, norm_g, ffn1_w_in, ffn1_w_out, ffn2_w_in, ffn2_w_out, ple_w_proj, ple_w_gate,
              even_w_in, even_w_out, hgrn_lb, hgrn_onorm_g, attn_sinks, odd_w_in, odd_w_out, ret_onorm_g):
    inv_b = ROPE_THETA ** (-jnp.arange(0, B_HEAD_DIM, 2, dtype=jnp.float32) / B_HEAD_DIM)
    inv_c = RET_THETA ** (-jnp.linspace(0.0, 1.0, C_DK // 2, dtype=jnp.float32))
    cos_b, sin_b = rope_tables(positions, inv_b)
    cos_c, sin_c = rope_tables(positions, inv_c)
    lb_all = jnp.cumsum(jax.nn.softmax(hgrn_lb.astype(jnp.float32), axis=0), axis=0)
    h = x
    for i in range(DEPTH):
        g = norm_g[i]
        h = h + 0.5 * rmsnorm(swiglu(rmsnorm(h, g[0]), ffn1_w_in[i], ffn1_w_out[i]), g[1])
        u = rmsnorm(h, g[2])
        j = i // 2
        if i % 2 == 0:
            mix = even_mixer(u, even_w_in[j], even_w_out[j], lb_all[j], hgrn_onorm_g[j], attn_sinks[j], cos_b, sin_b)
        else:
            mix = odd_mixer(u, odd_w_in[j], odd_w_out[j], ret_onorm_g[j], cos_c, sin_c)
        h = h + rmsnorm(mix, g[3])
        h = h + 0.5 * rmsnorm(swiglu(rmsnorm(h, g[4]), ffn2_w_in[i], ffn2_w_out[i]), g[5])
        gate = jax.nn.sigmoid(h @ ple_w_gate[i])
        h = h + rmsnorm(gate * (p[i] @ ple_w_proj[i]), g[6])
    return h
```

```cpp
#include <hip/hip_runtime.h>
#include <cstdio>
#include <cstdint>
namespace pg8 {
#define PG8_LAS __attribute__((address_space(3)))
typedef unsigned short bf16_t;
typedef short bf16x8 __attribute__((ext_vector_type(8)));
typedef float f32x4 __attribute__((ext_vector_type(4)));
typedef unsigned u32x4 __attribute__((ext_vector_type(4)));
constexpr int BM = 256, BK = 64, HALF = 128, HTB = HALF * BK * 2  , STAGE_BYTES = 8 * HTB, NXCD = 8, WGM = 8;

__host__ __device__ __forceinline__ int lds_byte(int r, int c) { const int st = (r >> 4) * 2 + (c >> 5), rr = r & 15, cc = c & 31, ob = rr * 64 + cc * 2; return st * 1024 + (ob ^ (((ob >> 9) & 1) << 5)); }
__host__ __device__ __forceinline__ void stage_rc(int b, int& R, int& C) { const int st = b / 1024, sb = b % 1024, swz = sb ^ (((sb >> 9) & 1) << 5); R = (st >> 1) * 16 + swz / 64; C = (st & 1) * 32 + (swz % 64) / 2; }
__host__ __device__ __forceinline__ int perm32(int rho) { const int n = rho >> 4, i = rho & 15; return 8 * (i >> 2) + 4 * n + (i & 3); }

struct Unit { int pm, pn; };
struct Gemm { const bf16_t* A; const bf16_t* Bt; int M, N, K; };

struct StaticOrder {
    int nM, nN, nwg, G, c;
    __host__ __device__ void init(int M, int N, int G_, int c_) { nM = M / BM; nN = N / BM; nwg = nM * nN; G = G_; c = c_; }
    __host__ __device__ bool next(int i, Unit& u) const {
        const long L = (long)i * G + c; if (L >= nwg) return false;
        int wgid = (int)L; { const int q = nwg / NXCD, r = nwg % NXCD, xcd = wgid % NXCD, off = wgid / NXCD; wgid = (xcd < r ? xcd * (q + 1) : r * (q + 1) + (xcd - r) * q) + off; }
        const int nig = WGM * nN, gid = wgid / nig, fm = gid * WGM, gsz = (nM - fm) < WGM ? (nM - fm) : WGM;
        u.pm = fm + ((wgid % nig) % gsz); u.pn = (wgid % nig) / gsz; return true;
    }
    __device__ __forceinline__ void a_ready(const Unit&) const {}
    __device__ __forceinline__ void done(const Unit&) const {}
};

__device__ __forceinline__ unsigned cvt_pk_bf16(float lo, float hi) { unsigned r; asm volatile("v_cvt_pk_bf16_f32 %0, %1, %2" : "=v"(r) : "v"(lo), "v"(hi)); return r; }
typedef float f32x2 __attribute__((ext_vector_type(2)));
__device__ __forceinline__ float fsigmoid(float x) { return __builtin_amdgcn_rcpf(1.0f + __builtin_amdgcn_exp2f(-1.4426950408889634f * x)); }
__device__ __forceinline__ float fsilu(float x) { return x * fsigmoid(x); }
__device__ __forceinline__ u32x4 pack8(const f32x4 v0, const f32x4 v1) { u32x4 w; w.x = cvt_pk_bf16(v0[0], v0[1]); w.y = cvt_pk_bf16(v0[2], v0[3]); w.z = cvt_pk_bf16(v1[0], v1[1]); w.w = cvt_pk_bf16(v1[2], v1[3]); return w; }
__device__ __forceinline__ float bflo(unsigned w) { return __uint_as_float(w << 16); }
__device__ __forceinline__ float bfhi(unsigned w) { return __uint_as_float(w & 0xffff0000u); }

struct EpiStore {
    static constexpr bool PERM = true, AFTER_DRAIN = false;
    bf16_t* O; int ldc;
    __device__ __forceinline__ void operator()(const f32x4 (&acc)[2][2][4][2], const Unit& u, int wr, int wc, int fr, int fq) const {
        const int row0 = u.pm * BM + wr * 64 + fr, col0 = u.pn * BM + wc * 32 + 8 * fq;
#pragma unroll
        for (int ai = 0; ai < 2; ++ai)
#pragma unroll
            for (int m = 0; m < 4; ++m) { bf16_t* rowp = O + (size_t)(row0 + ai * HALF + m * 16) * ldc + col0;
#pragma unroll
                for (int bj = 0; bj < 2; ++bj) *(u32x4*)(rowp + bj * HALF) = pack8(acc[ai][bj][m][0], acc[ai][bj][m][1]); }
    }
};
struct EpiSwiGLU {
    static constexpr bool PERM = true, AFTER_DRAIN = false;
    bf16_t* O; int ldc;
    __device__ __forceinline__ void operator()(const f32x4 (&acc)[2][2][4][2], const Unit& u, int wr, int wc, int fr, int fq) const {
        const int row0 = u.pm * BM + wr * 64 + fr, col0 = u.pn * HALF + wc * 32 + 8 * fq;
#pragma unroll
        for (int ai = 0; ai < 2; ++ai)
#pragma unroll
            for (int m = 0; m < 4; ++m) { bf16_t* rowp = O + (size_t)(row0 + ai * HALF + m * 16) * ldc + col0;
                f32x4 r0, r1;
#pragma unroll
                for (int j = 0; j < 4; ++j) { r0[j] = fsilu(acc[ai][0][m][0][j]) * acc[ai][1][m][0][j]; r1[j] = fsilu(acc[ai][0][m][1][j]) * acc[ai][1][m][1][j]; }
                *(u32x4*)rowp = pack8(r0, r1); }
    }
};
__device__ __forceinline__ void rope8(const f32x4 (&a0)[2], const f32x4 (&a1)[2], float p, const float (&invf)[2][4], float sc, f32x4 (&o1)[2], f32x4 (&o2)[2]) {
#pragma unroll
    for (int n = 0; n < 2; ++n)
#pragma unroll
        for (int j = 0; j < 4; ++j) { const float rev = __builtin_amdgcn_fractf(p * invf[n][j] * 0.15915494309189535f);
            const float s = __builtin_amdgcn_sinf(rev) * sc, c = __builtin_amdgcn_cosf(rev) * sc; const float x1 = a0[n][j], x2 = a1[n][j];
            o1[n][j] = x1 * c - x2 * s; o2[n][j] = x2 * c + x1 * s; }
}
struct EpiEvenIn {
    static constexpr bool PERM = true, AFTER_DRAIN = false;
    bf16_t* E; const int* pos;
    __device__ __forceinline__ void operator()(const f32x4 (&acc)[2][2][4][2], const Unit& u, int wr, int wc, int fr, int fq) const {
        const int row0 = u.pm * BM + wr * 64 + fr; constexpr int ldc = 2816;
        if (u.pn < 8 || (u.pn == 10 && wc >= 2)) {
            const int cb = (u.pn < 8) ? u.pn * BM + wc * 32 + 8 * fq : 2688 + 32 * (wc - 2) + 8 * fq; const int cs = (u.pn < 8) ? HALF : 64;
#pragma unroll
            for (int ai = 0; ai < 2; ++ai)
#pragma unroll
                for (int m = 0; m < 4; ++m) { bf16_t* rowp = E + (size_t)(row0 + ai * HALF + m * 16) * ldc + cb;
#pragma unroll
                    for (int bj = 0; bj < 2; ++bj) *(u32x4*)(rowp + bj * cs) = pack8(acc[ai][bj][m][0], acc[ai][bj][m][1]); }
        } else {
            const int cb = ((u.pn < 10) ? 2048 + (u.pn - 8) * BM + 64 * wc : 2560 + 64 * wc) + 8 * fq;
            float invf[2][4];
#pragma unroll
            for (int n = 0; n < 2; ++n)
#pragma unroll
                for (int j = 0; j < 4; ++j) invf[n][j] = __builtin_amdgcn_exp2f(-(float)(8 * fq + 4 * n + j) * (13.287712379549449f / 32.0f));
#pragma unroll
            for (int ai = 0; ai < 2; ++ai)
#pragma unroll
                for (int m = 0; m < 4; ++m) { const int row = row0 + ai * HALF + m * 16; const float p = (float)pos[row]; f32x4 o1[2], o2[2];
                    rope8(acc[ai][0][m], acc[ai][1][m], p, invf, 1.0f, o1, o2);
                    bf16_t* rowp = E + (size_t)row * ldc + cb; *(u32x4*)rowp = pack8(o1[0], o1[1]); *(u32x4*)(rowp + 32) = pack8(o2[0], o2[1]); }
        }
    }
};
struct EpiOddIn {
    static constexpr bool PERM = true, AFTER_DRAIN = false;
    bf16_t *Q, *K, *V, *G; const int* pos; const float* og;
    __device__ __forceinline__ void operator()(const f32x4 (&acc)[2][2][4][2], const Unit& u, int wr, int wc, int fr, int fq) const {
        const int row0 = u.pm * BM + wr * 64 + fr;
        if (u.pn < 8) {
            bf16_t* dst = (u.pn < 4) ? Q : K; const float sc = (u.pn < 4) ? 1.0f : 0.0625f; const int cb = (u.pn & 3) * BM + 32 * wc + 8 * fq;
            float invf[2][4];
#pragma unroll
            for (int n = 0; n < 2; ++n)
#pragma unroll
                for (int j = 0; j < 4; ++j) invf[n][j] = __builtin_amdgcn_exp2f(-(float)(32 * wc + 8 * fq + 4 * n + j) * (13.287712379549449f / 127.0f));
#pragma unroll
            for (int ai = 0; ai < 2; ++ai)
#pragma unroll
                for (int m = 0; m < 4; ++m) { const int row = row0 + ai * HALF + m * 16; const float p = (float)pos[row]; f32x4 o1[2], o2[2];
                    rope8(acc[ai][0][m], acc[ai][1][m], p, invf, sc, o1, o2);
                    bf16_t* rowp = dst + (size_t)row * 1024 + cb; *(u32x4*)rowp = pack8(o1[0], o1[1]); *(u32x4*)(rowp + HALF) = pack8(o2[0], o2[1]); }
        } else if (u.pn < 16) {
            const int cb = (u.pn - 8) * BM + wc * 32 + 8 * fq;
#pragma unroll
            for (int ai = 0; ai < 2; ++ai)
#pragma unroll
                for (int m = 0; m < 4; ++m) { bf16_t* rowp = V + (size_t)(row0 + ai * HALF + m * 16) * 2048 + cb;
#pragma unroll
                    for (int bj = 0; bj < 2; ++bj) *(u32x4*)(rowp + bj * HALF) = pack8(acc[ai][bj][m][0], acc[ai][bj][m][1]); }
        } else {
            const int cb = (u.pn - 16) * BM + wc * 32 + 8 * fq;
            f32x4 gv[2][2];
#pragma unroll
            for (int bj = 0; bj < 2; ++bj)
#pragma unroll
                for (int n = 0; n < 2; ++n) gv[bj][n] = *(const f32x4*)(og + ((cb + bj * HALF) & 511) + 4 * n);
#pragma unroll
            for (int ai = 0; ai < 2; ++ai)
#pragma unroll
                for (int m = 0; m < 4; ++m) { bf16_t* rowp = G + (size_t)(row0 + ai * HALF + m * 16) * 2048 + cb;
#pragma unroll
                    for (int bj = 0; bj < 2; ++bj) { f32x4 r0, r1;
#pragma unroll
                        for (int j = 0; j < 4; ++j) { r0[j] = fsilu(acc[ai][bj][m][0][j]) * gv[bj][0][j]; r1[j] = fsilu(acc[ai][bj][m][1][j]) * gv[bj][1][j]; }
                        *(u32x4*)(rowp + bj * HALF) = pack8(r0, r1); } }
        }
    }
};
struct EpiPleG {
    static constexpr bool PERM = true, AFTER_DRAIN = false;
    bf16_t* Z; const bf16_t* T;
    __device__ __forceinline__ void operator()(const f32x4 (&acc)[2][2][4][2], const Unit& u, int wr, int wc, int fr, int fq) const {
        const int row0 = u.pm * BM + wr * 64 + fr, col0 = u.pn * BM + wc * 32 + 8 * fq;
#pragma unroll
        for (int ai = 0; ai < 2; ++ai)
#pragma unroll
            for (int m = 0; m < 4; ++m) { const size_t off = (size_t)(row0 + ai * HALF + m * 16) * 1024 + col0;
#pragma unroll
                for (int bj = 0; bj < 2; ++bj) { const u32x4 t = *(const u32x4*)(T + off + bj * HALF); f32x4 r0, r1;
                    r0[0] = fsigmoid(acc[ai][bj][m][0][0]) * bflo(t.x); r0[1] = fsigmoid(acc[ai][bj][m][0][1]) * bfhi(t.x); r0[2] = fsigmoid(acc[ai][bj][m][0][2]) * bflo(t.y); r0[3] = fsigmoid(acc[ai][bj][m][0][3]) * bfhi(t.y);
                    r1[0] = fsigmoid(acc[ai][bj][m][1][0]) * bflo(t.z); r1[1] = fsigmoid(acc[ai][bj][m][1][1]) * bfhi(t.z); r1[2] = fsigmoid(acc[ai][bj][m][1][2]) * bflo(t.w); r1[3] = fsigmoid(acc[ai][bj][m][1][3]) * bfhi(t.w);
                    *(u32x4*)(Z + off + bj * HALF) = pack8(r0, r1); } }
    }
};

template <class Epi, class Sched, bool ALIGN_EPI = false, bool SP2 = false>
__device__ __forceinline__ void gemm_phase(PG8_LAS unsigned char* lds, const Gemm g, const Sched& S, const Epi& E) {
    int tid = threadIdx.x; asm volatile("" : "+v"(tid));
    const int wid = __builtin_amdgcn_readfirstlane(tid >> 6), lane = tid & 63, wr = wid >> 2, wc = wid & 3, fr = lane & 15, fq = lane >> 4;
    const int K = g.K, nt = K / BK;
    unsigned voffA[2], voffB[2];
#pragma unroll
    for (int i = 0; i < 2; ++i) { int R, C; stage_rc(tid * 16 + i * 8192, R, C); const int Rb = Epi::PERM ? ((R & ~31) + perm32(R & 31)) : R;
        voffA[i] = (unsigned)(R * K + C) * 2u; voffB[i] = (unsigned)(Rb * K + C) * 2u; }
    const size_t kstep = (size_t)(BK * 2);
    const size_t hstep = (size_t)HALF * K * 2;
    const size_t tstep = 2 * hstep;
    const unsigned ldsw = (unsigned)wid * 1024u;
    const int aoff = lds_byte(wr * 64 + fr, fq * 8), boff = lds_byte(wc * 32 + fr, fq * 8);
#define PG8_SA(b, h) (((b) * 2 + (h)) * HTB)
#define PG8_SB(b, h) ((4 + (b) * 2 + (h)) * HTB)
#define PG8_STAGE(bufoff, gbase, voff) do { _Pragma("unroll") for (int _i = 0; _i < 2; ++_i) \
        __builtin_amdgcn_global_load_lds((const unsigned*)((const char*)(gbase) + (voff)[_i]), (PG8_LAS unsigned*)(lds + (bufoff) + ldsw + _i * 8192), 16, 0, 0); } while (0)
#define PG8_LDA(dst, b, h) do { _Pragma("unroll") for (int m = 0; m < 4; ++m) _Pragma("unroll") for (int k = 0; k < 2; ++k) dst[m][k] = *(const PG8_LAS bf16x8*)(lds + PG8_SA(b, h) + aoff + m * 2048 + k * 1024); } while (0)
#define PG8_LDB(dst, b, h) do { _Pragma("unroll") for (int n = 0; n < 2; ++n) _Pragma("unroll") for (int k = 0; k < 2; ++k) dst[n][k] = *(const PG8_LAS bf16x8*)(lds + PG8_SB(b, h) + boff + n * 2048 + k * 1024); } while (0)
#define PG8_MMA(ai, bj, At, Bt) do { __builtin_amdgcn_s_setprio(1); _Pragma("unroll") for (int m = 0; m < 4; ++m) _Pragma("unroll") for (int n = 0; n < 2; ++n) _Pragma("unroll") for (int k = 0; k < 2; ++k) \
        acc[ai][bj][m][n] = __builtin_amdgcn_mfma_f32_16x16x32_bf16(Bt[n][k], At[m][k], acc[ai][bj][m][n], 0, 0, 0); __builtin_amdgcn_s_setprio(0); } while (0)
#define PG8_WAIT_V(n) asm volatile("s_waitcnt vmcnt(" #n ")" ::: "memory")
#define PG8_WAIT_L(n) asm volatile("s_waitcnt lgkmcnt(" #n ")" ::: "memory")
#define PG8_BAR __builtin_amdgcn_s_barrier()
#define PG8_SCHED __builtin_amdgcn_sched_barrier(0)
    Unit cur, nxt; int ui = 0;
    if (!S.next(0, cur)) return;
    f32x4 acc[2][2][4][2];
#pragma unroll
    for (int a = 0; a < 2; ++a)
#pragma unroll
        for (int b = 0; b < 2; ++b)
#pragma unroll
            for (int m = 0; m < 4; ++m)
#pragma unroll
                for (int n = 0; n < 2; ++n) acc[a][b][m][n] = (f32x4){0.f, 0.f, 0.f, 0.f};
    bf16x8 At[4][2], B0[2][2], B1[2][2];
    const char* cA = (const char*)g.A + (size_t)cur.pm * tstep; const char* cB = (const char*)g.Bt + (size_t)cur.pn * tstep;
    S.a_ready(cur);
    if constexpr (SP2) {
        PG8_STAGE(PG8_SB(0, 0), cB, voffB); PG8_STAGE(PG8_SB(0, 1), cB + hstep, voffB); PG8_STAGE(PG8_SA(0, 0), cA, voffA); PG8_STAGE(PG8_SA(0, 1), cA + hstep, voffA);
        if (wr == 1) PG8_BAR;
        PG8_WAIT_V(2); PG8_BAR;
        PG8_STAGE(PG8_SB(1, 0), cB + kstep, voffB); PG8_STAGE(PG8_SA(1, 0), cA + kstep, voffA); PG8_STAGE(PG8_SB(1, 1), cB + hstep + kstep, voffB);
        PG8_WAIT_V(6); PG8_BAR;
    } else {
        PG8_STAGE(PG8_SB(0, 0), cB, voffB); PG8_STAGE(PG8_SA(0, 0), cA, voffA); PG8_STAGE(PG8_SB(0, 1), cB + hstep, voffB); PG8_STAGE(PG8_SA(0, 1), cA + hstep, voffA);
        if (wr == 1) PG8_BAR;
        PG8_WAIT_V(4); PG8_BAR;
        PG8_STAGE(PG8_SB(1, 0), cB + kstep, voffB); PG8_STAGE(PG8_SA(1, 0), cA + kstep, voffA); PG8_STAGE(PG8_SB(1, 1), cB + hstep + kstep, voffB);
        PG8_WAIT_V(6); PG8_BAR;
    }
    for (;;) {
        const bool has_next = S.next(ui + 1, nxt);
        const char* nA = has_next ? (const char*)g.A + (size_t)nxt.pm * tstep : cA; const char* nB = has_next ? (const char*)g.Bt + (size_t)nxt.pn * tstep : cB;
        for (int t = 0; t < nt; t += 2) {
            const bool last = (t == nt - 2);
            const char* a1 = cA + (size_t)(t + 1) * kstep;
            const char* a2 = last ? nA : cA + (size_t)(t + 2) * kstep; const char* b2 = last ? nB : cB + (size_t)(t + 2) * kstep;
            const char* a3 = a2 + kstep; const char* b3 = b2 + kstep;
            if (last && has_next) S.a_ready(nxt);
            if constexpr (SP2) {
            PG8_LDB(B0, 0, 0); PG8_LDB(B1, 0, 1); PG8_SCHED; PG8_LDA(At, 0, 0); PG8_STAGE(PG8_SA(1, 1), a1 + hstep, voffA);
            PG8_WAIT_V(8); PG8_WAIT_L(0); PG8_BAR; PG8_MMA(0, 0, At, B0); PG8_MMA(0, 1, At, B1); PG8_BAR; PG8_SCHED;
            PG8_LDA(At, 0, 1); PG8_STAGE(PG8_SB(0, 0), b2, voffB); PG8_STAGE(PG8_SB(0, 1), b2 + hstep, voffB); PG8_STAGE(PG8_SA(0, 0), a2, voffA);
            PG8_WAIT_V(8); PG8_WAIT_L(0); PG8_BAR; PG8_MMA(1, 0, At, B0); PG8_MMA(1, 1, At, B1); PG8_BAR; PG8_SCHED;
            PG8_LDB(B0, 1, 0); PG8_LDB(B1, 1, 1); PG8_SCHED; PG8_LDA(At, 1, 0); PG8_STAGE(PG8_SA(0, 1), a2 + hstep, voffA);
            PG8_WAIT_V(8); PG8_WAIT_L(0); PG8_BAR; PG8_MMA(0, 0, At, B0); PG8_MMA(0, 1, At, B1); PG8_BAR; PG8_SCHED;
            PG8_LDA(At, 1, 1); PG8_STAGE(PG8_SB(1, 0), b3, voffB); PG8_STAGE(PG8_SB(1, 1), b3 + hstep, voffB); PG8_STAGE(PG8_SA(1, 0), a3, voffA);
            PG8_WAIT_V(8); PG8_WAIT_L(0); PG8_BAR; PG8_MMA(1, 0, At, B0); PG8_MMA(1, 1, At, B1); PG8_BAR; PG8_SCHED;
            } else {
            PG8_LDB(B0, 0, 0); PG8_SCHED; PG8_LDA(At, 0, 0); PG8_STAGE(PG8_SA(1, 1), a1 + hstep, voffA);
            PG8_WAIT_L(8); PG8_BAR; PG8_WAIT_L(0); PG8_MMA(0, 0, At, B0); PG8_BAR; PG8_SCHED;
            PG8_LDB(B1, 0, 1); PG8_STAGE(PG8_SB(0, 0), b2, voffB);
            PG8_BAR; PG8_WAIT_L(0); PG8_MMA(0, 1, At, B1); PG8_BAR;
            PG8_LDA(At, 0, 1); PG8_STAGE(PG8_SA(0, 0), a2, voffA);
            PG8_BAR; PG8_WAIT_L(0); PG8_MMA(1, 0, At, B0); PG8_BAR; PG8_SCHED;
            PG8_STAGE(PG8_SB(0, 1), b2 + hstep, voffB);
            PG8_WAIT_V(6); PG8_BAR; PG8_MMA(1, 1, At, B1); PG8_BAR;
            PG8_LDB(B0, 1, 0); PG8_SCHED; PG8_LDA(At, 1, 0); PG8_STAGE(PG8_SA(0, 1), a2 + hstep, voffA);
            PG8_WAIT_L(8); PG8_BAR; PG8_WAIT_L(0); PG8_MMA(0, 0, At, B0); PG8_BAR; PG8_SCHED;
            PG8_LDB(B1, 1, 1); PG8_STAGE(PG8_SB(1, 0), b3, voffB);
            PG8_BAR; PG8_WAIT_L(0); PG8_MMA(0, 1, At, B1); PG8_BAR;
            PG8_LDA(At, 1, 1); PG8_STAGE(PG8_SA(1, 0), a3, voffA);
            PG8_BAR; PG8_WAIT_L(0); PG8_MMA(1, 0, At, B0); PG8_BAR; PG8_SCHED;
            PG8_STAGE(PG8_SB(1, 1), b3 + hstep, voffB);
            PG8_WAIT_V(6); PG8_BAR; PG8_MMA(1, 1, At, B1); PG8_BAR;
            }
        }
        if constexpr (ALIGN_EPI) { if (wr == 0) PG8_BAR; }
        if constexpr (!Epi::AFTER_DRAIN) { E(acc, cur, wr, wc, fr, fq); S.done(cur); }
        if (!has_next) break;
#pragma unroll
        for (int a = 0; a < 2; ++a)
#pragma unroll
            for (int b = 0; b < 2; ++b)
#pragma unroll
                for (int m = 0; m < 4; ++m)
#pragma unroll
                    for (int n = 0; n < 2; ++n) acc[a][b][m][n] = (f32x4){0.f, 0.f, 0.f, 0.f};
        cur = nxt; cA = nA; cB = nB; ++ui;
        if constexpr (ALIGN_EPI) { if (wr == 1) PG8_BAR; }
    }
    PG8_WAIT_V(0);
    if constexpr (!ALIGN_EPI) { if (wr == 0) PG8_BAR; }
    PG8_BAR;
    if constexpr (Epi::AFTER_DRAIN) { E.fused(acc, cur, wr, wc, fr, fq, lds, wid, lane); S.done(cur); }
#undef PG8_SA
#undef PG8_SB
#undef PG8_STAGE
#undef PG8_LDA
#undef PG8_LDB
#undef PG8_MMA
#undef PG8_WAIT_V
#undef PG8_WAIT_L
#undef PG8_BAR
#undef PG8_SCHED
}
}

#define GAS __attribute__((address_space(1)))
#define LAS __attribute__((address_space(3)))
typedef unsigned short bf16;
typedef unsigned v4u __attribute__((ext_vector_type(4)));
typedef float f32x4 __attribute__((ext_vector_type(4)));
typedef short bf16x8 __attribute__((ext_vector_type(8)));
typedef GAS unsigned gu32;
typedef GAS unsigned long long gu64;
#define RLX_AGENT __ATOMIC_RELAXED, __HIP_MEMORY_SCOPE_AGENT
#define LDS_WAIT() asm volatile("s_waitcnt lgkmcnt(0)" ::: "memory")
#define VM_WAIT() asm volatile("s_waitcnt vmcnt(0)" ::: "memory")
__device__ __forceinline__ unsigned long long rt() { return __builtin_amdgcn_s_memrealtime(); }
__device__ __forceinline__ unsigned f2bf(float f) { unsigned u = __builtin_bit_cast(unsigned, f); return (u + 0x7fffu + ((u >> 16) & 1u)) >> 16; }
__device__ __forceinline__ unsigned pk2(float lo, float hi) { return f2bf(lo) | (f2bf(hi) << 16); }

#define XB_TMO      128
#define XB_XCNT(j)  (256  + 64 * (j))
#define XB_XSUB(j)  (1280 + 64 * (j))
#define XB_XGEN(j)  (2304 + 64 * (j))
#define XB_TOP      3328
#define XB_TOPGEN   3392
#define XCD_BAR_WORDS 3456
#define XB_SPIN_CAP (1u << 22)

__device__ __forceinline__ unsigned xb_ld(unsigned* p)              { return __hip_atomic_load(p, __ATOMIC_RELAXED, __HIP_MEMORY_SCOPE_AGENT); }
__device__ __forceinline__ unsigned xb_add(unsigned* p, unsigned v) { return __hip_atomic_fetch_add(p, v, __ATOMIC_RELAXED, __HIP_MEMORY_SCOPE_AGENT); }
__device__ __forceinline__ unsigned xb_xcc_id() { return (unsigned)__builtin_amdgcn_s_getreg((3 << 11) | 20) & 0xFu; }
#define XB_SPIN(cond, bar) do { unsigned _sp = 0; while (cond) { __builtin_amdgcn_s_sleep(1); \
    if ((++_sp & 255u) == 0u) { if (xb_ld(&(bar)[XB_TMO])) break; if (_sp > XB_SPIN_CAP) { atomicAdd(&(bar)[XB_TMO], 1u); break; } } } } while (0)

struct XcdBarrier {
    unsigned* bar; unsigned x;
    volatile LAS unsigned* st;
};

__device__ __forceinline__ XcdBarrier xcd_barrier_post(unsigned* bar, volatile LAS unsigned* st) {
    XcdBarrier b; b.bar = bar; b.x = xb_xcc_id(); b.st = st;
    if (threadIdx.x == 0) (void)xb_add(&bar[XB_XCNT(b.x)], 1u);
    return b;
}
__device__ __forceinline__ void xcd_barrier_complete(unsigned* bar, unsigned x, unsigned& nloc, unsigned& nx) {
    const unsigned G = gridDim.x * gridDim.y * gridDim.z;
    unsigned sum, cnt, mine, sp = 0u;
    for (;;) {
        sum = 0u; cnt = 0u; mine = 0u;
#pragma unroll
        for (unsigned j = 0; j < 16; ++j) { const unsigned c = xb_ld(&bar[XB_XCNT(j)]); sum += c; cnt += (c > 0u) ? 1u : 0u; mine = (j == x) ? c : mine; }
        if (sum == G) break;
        __builtin_amdgcn_s_sleep(1);
        if ((++sp & 255u) == 0u) { if (xb_ld(&bar[XB_TMO])) break; if (sp > XB_SPIN_CAP) { atomicAdd(&bar[XB_TMO], 1u); break; } }
    }
    nloc = mine > 0u ? mine : 1u; nx = cnt > 0u ? cnt : 1u;
}

__device__ __forceinline__ void xcd_barrier(const XcdBarrier& b) {
    asm volatile("s_waitcnt vmcnt(0)" ::: "memory");
    __syncthreads();
    if (threadIdx.x == 0) {
        unsigned* bar = b.bar; asm volatile("" : "+s"(bar));
        __builtin_amdgcn_s_waitcnt(0);
        unsigned nloc = b.st[0], nx = b.st[1];
        if (nloc == 0u) { xcd_barrier_complete(bar, b.x, nloc, nx); b.st[0] = nloc; b.st[1] = nx; }
        const unsigned old = xb_add(&bar[XB_XSUB(b.x)], 1u);
        const unsigned gen = old / nloc;
        if (old + 1u == (gen + 1u) * nloc) {
            __builtin_amdgcn_fence(__ATOMIC_RELEASE, "agent");
            asm volatile("s_waitcnt vmcnt(0)" ::: "memory");
            const unsigned og = xb_add(&bar[XB_TOP], 1u);
            const unsigned tg = og / nx;
            if (og + 1u == (tg + 1u) * nx) xb_add(&bar[XB_TOPGEN], 1u);
            else XB_SPIN(xb_ld(&bar[XB_TOPGEN]) == tg, bar);
            __builtin_amdgcn_fence(__ATOMIC_ACQUIRE, "agent");
            xb_add(&bar[XB_XGEN(b.x)], 1u);
            asm volatile("s_waitcnt vmcnt(0)" ::: "memory");
        } else {
            XB_SPIN(xb_ld(&bar[XB_XGEN(b.x)]) == gen, bar);
            __builtin_amdgcn_fence(__ATOMIC_ACQUIRE, "agent");
            asm volatile("s_waitcnt vmcnt(0)" ::: "memory");
        }
    }
    __syncthreads();
}

constexpr int NWAVES = 8;
constexpr int BATCH = 8, SEQ = 8192, D = 1024, FF = 2816, PLE = 256, DEPTH = 2;
constexpr int M = BATCH * SEQ;
constexpr int EVEN_IN = 2816, ODD_IN = 6144;
constexpr float EPS = 1e-6f;
constexpr size_t MiB = 1u << 20;
constexpr size_t WS_CTL = 0, CTL_ZERO_BYTES = 2 * MiB;
constexpr size_t WS_SSQ = 1 * MiB;
constexpr size_t WS_WB = 2 * MiB;
constexpr size_t W_LAYER = 71 * MiB / 2;
constexpr size_t WO_1IN = 0, WO_1OUT = 11 * MiB, WO_2IN = WO_1OUT + 11 * MiB / 2, WO_2OUT = WO_2IN + 11 * MiB, WO_PROJ = WO_2OUT + 11 * MiB / 2, WO_GATE = WO_PROJ + MiB / 2;
static_assert(WO_GATE + 2 * MiB == W_LAYER, "weight map");
constexpr size_t WS_WEVIN = WS_WB + 2 * W_LAYER, WS_WEVOUT = WS_WEVIN + 11 * MiB / 2, WS_WODIN = WS_WEVOUT + 2 * MiB, WS_WODOUT = WS_WODIN + 12 * MiB, WS_WEND = WS_WODOUT + 4 * MiB;
constexpr size_t WS_YN = 98 * MiB;
static_assert(WS_WEND <= WS_YN, "weights fit");
constexpr size_t WS_BIG = WS_YN + 128 * MiB;
constexpr size_t WS_END = WS_BIG + 768 * MiB;
constexpr size_t BIG_ACT = 0, BIG_E = 0, BIG_OAB = 352 * MiB, BIG_SCR = 480 * MiB;
constexpr size_t BIG_Q = 0, BIG_K = 128 * MiB, BIG_V = 256 * MiB, BIG_G = 512 * MiB;
constexpr size_t BIG_Z = 0, BIG_PB = 128 * MiB, BIG_T = 256 * MiB;
constexpr int CW_BAR = 4096;
constexpr int RING_OFF = 0, RING_BYTES = 131072;
constexpr int LDSCTL_OFF = RING_BYTES, MISC_OFF = LDSCTL_OFF + 320;
constexpr int LDS_BYTES = 147456;

struct Frame {
    LAS unsigned char* lds;
    volatile LAS unsigned* MISC;
    gu32* ctl;
    int tid, lane, wave, vcu, G;
};

__device__ __forceinline__ float wave_sum(float v) {
#pragma unroll
    for (int o = 1; o < 64; o <<= 1) v += __shfl_xor(v, o);
    return v;
}
__device__ __forceinline__ float wave_max(float v) {
#pragma unroll
    for (int o = 1; o < 64; o <<= 1) v = fmaxf(v, __shfl_xor(v, o));
    return v;
}
__device__ __forceinline__ float bf2f(bf16 b) { return __uint_as_float(((unsigned)b) << 16); }
__device__ __forceinline__ float blo(unsigned w) { return __uint_as_float(w << 16); }
__device__ __forceinline__ float bhi(unsigned w) { return __uint_as_float(w & 0xffff0000u); }
__device__ __forceinline__ float fsig(float x) { return 1.0f / (1.0f + __expf(-x)); }
__device__ __forceinline__ void unpack8(const v4u w, float (&f)[8]) { f[0] = blo(w.x); f[1] = bhi(w.x); f[2] = blo(w.y); f[3] = bhi(w.y); f[4] = blo(w.z); f[5] = bhi(w.z); f[6] = blo(w.w); f[7] = bhi(w.w); }
__device__ __forceinline__ v4u pack8f(const float (&f)[8]) { v4u w; w.x = pk2(f[0], f[1]); w.y = pk2(f[2], f[3]); w.z = pk2(f[4], f[5]); w.w = pk2(f[6], f[7]); return w; }

__device__ __forceinline__ void transpose_item(const float* W, int K, int Nsrc, bf16* WT, int dr0, int sc0, int k0, LAS float* scr, int lane) {
#pragma unroll 8
    for (int i = 0; i < 32; ++i) { const int kk = 2 * i + (lane >> 5); scr[kk * 33 + (lane & 31)] = W[(size_t)(k0 + kk) * Nsrc + sc0 + (lane & 31)]; }
    LDS_WAIT(); asm volatile("" ::: "memory");
    const int c = lane & 7;
#pragma unroll
    for (int j = 0; j < 4; ++j) { const int n = (lane >> 3) + 8 * j; const LAS float* s = scr + (8 * c) * 33 + n;
        v4u o; o.x = pk2(s[0 * 33], s[1 * 33]); o.y = pk2(s[2 * 33], s[3 * 33]); o.z = pk2(s[4 * 33], s[5 * 33]); o.w = pk2(s[6 * 33], s[7 * 33]);
        *(GAS v4u*)(WT + (size_t)(dr0 + n) * K + k0 + 8 * c) = o; }
    LDS_WAIT(); asm volatile("" ::: "memory");
}
__device__ __forceinline__ int ffn_src_col(int n0) { const int pn = n0 >> 8, bj = (n0 >> 7) & 1, w = n0 & 127; return bj * FF + 128 * pn + w; }
__device__ __forceinline__ int even_src_col(int n0) {
    const int pn = n0 >> 8; if (pn < 8) return n0;
    const int bj = (n0 >> 7) & 1, wc = (n0 >> 5) & 3;
    if (pn < 10) return 256 * pn + 64 * wc + 32 * bj;
    if (wc < 2) return 2560 + 64 * wc + 32 * bj;
    return 2688 + 64 * bj + 32 * (wc - 2);
}
template <int MAP> __device__ __forceinline__ void conv_matrix(Frame& F, const float* W, int K, int N, bf16* WT, LAS float* scr) {
    int lane = F.lane; asm volatile("" : "+v"(lane));
    const int gw = F.vcu * NWAVES + F.wave, NGW = F.G * NWAVES, nblk = N / 32, nitems = (K / 64) * nblk;
    for (int it = gw; it < nitems; it += NGW) { const int kb = it / nblk, nb = it % nblk, n0 = 32 * nb;
        const int sc0 = MAP == 0 ? n0 : (MAP == 1 ? ffn_src_col(n0) : even_src_col(n0));
        transpose_item(W, K, N, WT, n0, sc0, 64 * kb, scr, lane); }
}

__device__ __forceinline__ void load_g16(const float* g, int lane, float (&o)[16]) {
#pragma unroll
    for (int j = 0; j < 2; ++j) { const f32x4 a = *(const f32x4*)(g + 8 * lane + 512 * j), b = *(const f32x4*)(g + 8 * lane + 512 * j + 4);
        o[8 * j + 0] = a.x; o[8 * j + 1] = a.y; o[8 * j + 2] = a.z; o[8 * j + 3] = a.w; o[8 * j + 4] = b.x; o[8 * j + 5] = b.y; o[8 * j + 6] = b.z; o[8 * j + 7] = b.w; }
}
__device__ __forceinline__ void load_h16(const float* hrow, int lane, float (&o)[16]) { load_g16(hrow, lane, o); }
__device__ __forceinline__ void store_h16(float* hrow, int lane, const float (&o)[16]) {
#pragma unroll
    for (int j = 0; j < 2; ++j) { *(f32x4*)(hrow + 8 * lane + 512 * j) = (f32x4){o[8 * j], o[8 * j + 1], o[8 * j + 2], o[8 * j + 3]}; *(f32x4*)(hrow + 8 * lane + 512 * j + 4) = (f32x4){o[8 * j + 4], o[8 * j + 5], o[8 * j + 6], o[8 * j + 7]}; }
}
__device__ __forceinline__ void store_b16(bf16* row, int lane, const float (&o)[16]) {
#pragma unroll
    for (int j = 0; j < 2; ++j) { v4u w; w.x = pk2(o[8 * j], o[8 * j + 1]); w.y = pk2(o[8 * j + 2], o[8 * j + 3]); w.z = pk2(o[8 * j + 4], o[8 * j + 5]); w.w = pk2(o[8 * j + 6], o[8 * j + 7]); *(v4u*)(row + 8 * lane + 512 * j) = w; }
}
__device__ __forceinline__ void norm_rows(Frame& F, const float* x, const float* g, bf16* YN) {
    int lane = F.lane; asm volatile("" : "+v"(lane));
    const int gw = F.vcu * NWAVES + F.wave, NGW = F.G * NWAVES;
    float gg[16]; load_g16(g, lane, gg);
    for (int m = gw; m < M; m += NGW) { float h[16]; load_h16(x + (size_t)m * D, lane, h); float s = 0.f;
#pragma unroll
        for (int i = 0; i < 16; ++i) s += h[i] * h[i];
        const float rstd = rsqrtf(wave_sum(s) * (1.0f / D) + EPS);
#pragma unroll
        for (int i = 0; i < 16; ++i) h[i] = h[i] * rstd * gg[i];
        store_b16(YN + (size_t)m * D, lane, h); }
}
template <bool NORM2, bool WRITE_YN, bool CONV_P>
__device__ __forceinline__ void thin_pass(Frame& F, const float* hin, const bf16* Y, const float* gA, float c, float* hout, const float* gB, bf16* YNo, const float* psrc, bf16* PBo) {
    int lane = F.lane; asm volatile("" : "+v"(lane));
    const int gw = F.vcu * NWAVES + F.wave, NGW = F.G * NWAVES;
    float ga[16], gb[16]; load_g16(gA, lane, ga);
    if (NORM2) load_g16(gB, lane, gb);
    for (int m = gw; m < M; m += NGW) {
        float y[16], h[16];
#pragma unroll
        for (int j = 0; j < 2; ++j) { const v4u w = *(const v4u*)(Y + (size_t)m * D + 8 * lane + 512 * j);
            y[8 * j + 0] = blo(w.x); y[8 * j + 1] = bhi(w.x); y[8 * j + 2] = blo(w.y); y[8 * j + 3] = bhi(w.y); y[8 * j + 4] = blo(w.z); y[8 * j + 5] = bhi(w.z); y[8 * j + 6] = blo(w.w); y[8 * j + 7] = bhi(w.w); }
        load_h16(hin + (size_t)m * D, lane, h);
        float s = 0.f;
#pragma unroll
        for (int i = 0; i < 16; ++i) s += y[i] * y[i];
        const float rstd = rsqrtf(wave_sum(s) * (1.0f / D) + EPS) * c;
#pragma unroll
        for (int i = 0; i < 16; ++i) h[i] = h[i] + y[i] * rstd * ga[i];
        store_h16(hout + (size_t)m * D, lane, h);
        if (WRITE_YN) {
            if (NORM2) { float s2 = 0.f;
#pragma unroll
                for (int i = 0; i < 16; ++i) s2 += h[i] * h[i];
                const float r2 = rsqrtf(wave_sum(s2) * (1.0f / D) + EPS);
#pragma unroll
                for (int i = 0; i < 16; ++i) h[i] = h[i] * r2 * gb[i]; }
            store_b16(YNo + (size_t)m * D, lane, h); }
        if (CONV_P) { const f32x4 pv = *(const f32x4*)(psrc + (size_t)m * PLE + 4 * lane);
            *(unsigned long long*)(PBo + (size_t)m * PLE + 4 * lane) = (unsigned long long)pk2(pv.x, pv.y) | ((unsigned long long)pk2(pv.z, pv.w) << 32); }
    }
}

__device__ __forceinline__ void naive_hgrn2(Frame& F, const bf16* E, const float* hgrn_lb, float* SCR) {
    int lane = F.lane; asm volatile("" : "+v"(lane)); const int gw = F.vcu * NWAVES + F.wave, NGW = F.G * NWAVES;
    for (int unit = gw; unit < 256; unit += NGW) {
        const int b = unit >> 5, h = (unit >> 3) & 3, vg = unit & 7;
        const float lb0 = fsig(hgrn_lb[h * 128 + lane] - hgrn_lb[512 + h * 128 + lane]), lb1 = fsig(hgrn_lb[h * 128 + 64 + lane] - hgrn_lb[512 + h * 128 + 64 + lane]);
        float s0[16], s1[16];
#pragma unroll
        for (int j = 0; j < 16; ++j) { s0[j] = 0.f; s1[j] = 0.f; }
        const bf16* e = E + (size_t)b * SEQ * EVEN_IN; float* so = SCR + (size_t)b * SEQ * 512 + h * 128 + vg * 16;
        for (int t = 0; t < SEQ; ++t, e += EVEN_IN, so += 512) {
            float q0 = bf2f(e[h * 128 + lane]), q1 = bf2f(e[h * 128 + 64 + lane]);
            const float fl0 = bf2f(e[512 + h * 128 + lane]), fl1 = bf2f(e[512 + h * 128 + 64 + lane]);
            q0 = q0 * fsig(q0); q1 = q1 * fsig(q1);
            const float f0 = lb0 + (1.0f - lb0) * fsig(fl0), f1 = lb1 + (1.0f - lb1) * fsig(fl1), k0 = 1.0f - f0, k1 = 1.0f - f1;
            float v[16]; { float t8[8]; unpack8(*(const v4u*)(e + 1024 + h * 128 + vg * 16), t8);
#pragma unroll
                for (int j = 0; j < 8; ++j) v[j] = t8[j];
                unpack8(*(const v4u*)(e + 1024 + h * 128 + vg * 16 + 8), t8);
#pragma unroll
                for (int j = 0; j < 8; ++j) v[8 + j] = t8[j]; }
            float myo = 0.f;
#pragma unroll
            for (int j = 0; j < 16; ++j) { s0[j] = f0 * s0[j] + k0 * v[j]; s1[j] = f1 * s1[j] + k1 * v[j]; const float o = wave_sum(q0 * s0[j] + q1 * s1[j]); if (lane == j) myo = o; }
            if (lane < 16) so[lane] = myo;
        }
    }
}
__device__ __forceinline__ void hgrn_norm(Frame& F, const float* SCR, const bf16* E, const float* og, bf16* OAB) {
    int lane = F.lane; asm volatile("" : "+v"(lane)); const int gw = F.vcu * NWAVES + F.wave, NGW = F.G * NWAVES;
    const float g0 = og[lane], g1 = og[64 + lane];
    for (int u = gw; u < M * 4; u += NGW) { const int row = u >> 2, h = u & 3;
        const float o0 = SCR[(size_t)row * 512 + h * 128 + lane], o1 = SCR[(size_t)row * 512 + h * 128 + 64 + lane];
        const float rstd = rsqrtf(wave_sum(o0 * o0 + o1 * o1) * (1.0f / 128.0f) + EPS);
        const float a0 = bf2f(E[(size_t)row * EVEN_IN + 1536 + h * 128 + lane]), a1 = bf2f(E[(size_t)row * EVEN_IN + 1536 + h * 128 + 64 + lane]);
        OAB[(size_t)row * D + h * 128 + lane] = (bf16)f2bf(o0 * rstd * g0 * a0 * fsig(a0)); OAB[(size_t)row * D + h * 128 + 64 + lane] = (bf16)f2bf(o1 * rstd * g1 * a1 * fsig(a1)); }
}
__device__ __forceinline__ void naive_swa(Frame& F, const bf16* E, const float* sinks, bf16* OAB) {
    int lane = F.lane; asm volatile("" : "+v"(lane)); const int gw = F.vcu * NWAVES + F.wave, NGW = F.G * NWAVES;
    for (int unit = gw; unit < M * 8; unit += NGW) {
        const int row = unit >> 3, hq = unit & 7, g = hq >> 2, t = row & (SEQ - 1);
        float q[64];
#pragma unroll
        for (int i = 0; i < 8; ++i) { float t8[8]; unpack8(*(const v4u*)(E + (size_t)row * EVEN_IN + 2048 + hq * 64 + 8 * i), t8);
#pragma unroll
            for (int j = 0; j < 8; ++j) q[8 * i + j] = t8[j]; }
        float sc[2];
#pragma unroll
        for (int kk = 0; kk < 2; ++kk) { const int jt = t - 127 + lane + 64 * kk; const bool valid = jt >= 0; const int jr = valid ? jt : 0;
            const bf16* kp = E + (size_t)(row - t + jr) * EVEN_IN + 2560 + g * 64; float dot = 0.f;
#pragma unroll
            for (int i = 0; i < 8; ++i) { float t8[8]; unpack8(*(const v4u*)(kp + 8 * i), t8);
#pragma unroll
                for (int j = 0; j < 8; ++j) dot += q[8 * i + j] * t8[j]; }
            sc[kk] = valid ? dot * 0.125f : -__builtin_inff(); }
        const float sink = sinks[hq];
        const float mx = fmaxf(wave_max(fmaxf(sc[0], sc[1])), sink);
        const float p0 = __expf(sc[0] - mx), p1 = __expf(sc[1] - mx);
        const float denom = wave_sum(p0 + p1) + __expf(sink - mx);
        float o = 0.f;
        for (int j = 0; j < 128; ++j) { const int jt = t - 127 + j; const float pj = __shfl(j < 64 ? p0 : p1, j & 63);
            if (jt >= 0) o += pj * bf2f(E[(size_t)(row - t + jt) * EVEN_IN + 2688 + g * 64 + lane]); }
        OAB[(size_t)row * D + 512 + hq * 64 + lane] = (bf16)f2bf(o / denom);
    }
}
__device__ __forceinline__ void naive_retention(Frame& F, const bf16* Q, const bf16* K, bf16* V, float* SSQ) {
    int lane = F.lane; asm volatile("" : "+v"(lane)); const int gw = F.vcu * NWAVES + F.wave, NGW = F.G * NWAVES;
    for (int unit = gw; unit < 2048; unit += NGW) {
        const int b = unit >> 8, h = (unit >> 6) & 3, v8 = unit & 63;
        const float gamma = 1.0f - exp2f(-5.0f - (float)h);
        float s[4][8];
#pragma unroll
        for (int i = 0; i < 4; ++i)
#pragma unroll
            for (int j = 0; j < 8; ++j) s[i][j] = 0.f;
        for (int t = 0; t < SEQ; ++t) { const size_t row = (size_t)b * SEQ + t;
            float q[4], k[4];
#pragma unroll
            for (int i = 0; i < 4; ++i) { q[i] = bf2f(Q[row * 1024 + h * 256 + lane + 64 * i]); k[i] = bf2f(K[row * 1024 + h * 256 + lane + 64 * i]); }
            float v[8]; unpack8(*(const v4u*)(V + row * 2048 + h * 512 + v8 * 8), v);
            float o[8]; float ss = 0.f;
#pragma unroll
            for (int j = 0; j < 8; ++j) { float a = 0.f;
#pragma unroll
                for (int i = 0; i < 4; ++i) { s[i][j] = gamma * s[i][j] + k[i] * v[j]; a += q[i] * s[i][j]; }
                o[j] = wave_sum(a); ss += o[j] * o[j]; }
            if (lane == 0) { *(v4u*)(V + row * 2048 + h * 512 + v8 * 8) = pack8f(o); atomicAdd(SSQ + row * 4 + h, ss); }
        }
    }
}
__device__ __forceinline__ void ret_norm(Frame& F, bf16* V, const bf16* G, const float* SSQ) {
    int lane = F.lane; asm volatile("" : "+v"(lane)); const int gw = F.vcu * NWAVES + F.wave, NGW = F.G * NWAVES;
    for (int m = gw; m < M; m += NGW) {
#pragma unroll
        for (int j = 0; j < 4; ++j) { const float rstd = rsqrtf(SSQ[(size_t)m * 4 + j] * (1.0f / 512.0f) + EPS);
            float o[8], g[8]; unpack8(*(const v4u*)(V + (size_t)m * 2048 + 512 * j + 8 * lane), o); unpack8(*(const v4u*)(G + (size_t)m * 2048 + 512 * j + 8 * lane), g);
#pragma unroll
            for (int i = 0; i < 8; ++i) o[i] = o[i] * rstd * g[i];
            *(v4u*)(V + (size_t)m * 2048 + 512 * j + 8 * lane) = pack8f(o); }
    }
}

struct Args { const float* in[18]; float* out; unsigned char* ws; };
__global__ void __launch_bounds__(NWAVES * 64, 2) mk_fwd(Args args) {
    extern __shared__ __attribute__((aligned(16))) unsigned char lds[];
    Frame F;
    F.lds = (LAS unsigned char*)lds;
    F.MISC = (volatile LAS unsigned*)(F.lds + MISC_OFF);
    F.tid = threadIdx.x; F.lane = F.tid & 63; F.wave = __builtin_amdgcn_readfirstlane(F.tid >> 6);
    F.G = gridDim.x; { const int bx = blockIdx.x; F.vcu = (F.G % 8 == 0) ? (bx % 8) * (F.G / 8) + bx / 8 : bx; }
    unsigned char* ws = args.ws;
    F.ctl = (gu32*)(ws + WS_CTL);
    for (int u = F.tid; u < (LDS_BYTES - LDSCTL_OFF) / 4; u += NWAVES * 64) ((LAS unsigned*)(F.lds + LDSCTL_OFF))[u] = 0u;
    __syncthreads();
    XcdBarrier bar = xcd_barrier_post((unsigned*)(F.ctl + CW_BAR), F.MISC + 8);
#define GRID_BAR() xcd_barrier(bar)
    const float* x = args.in[0]; const float* p_in = args.in[1]; const int* positions = (const int*)args.in[2]; const float* norm_g = args.in[3];
    const float* hgrn_lb = args.in[12]; const float* hgrn_og = args.in[13]; const float* sinks = args.in[14]; const float* ret_og = args.in[17];
    float* H = args.out;
    bf16* YN = (bf16*)(ws + WS_YN); unsigned char* BIG = ws + WS_BIG; float* SSQ = (float*)(ws + WS_SSQ);
    PG8_LAS unsigned char* ring = (PG8_LAS unsigned char*)(F.lds + RING_OFF);

    {
        LAS float* scr = (LAS float*)(F.lds + RING_OFF + F.wave * 16384);
        for (int l = 0; l < DEPTH; ++l) { unsigned char* wl = ws + WS_WB + l * W_LAYER;
            conv_matrix<1>(F, args.in[4] + (size_t)l * D * 2 * FF, D, 2 * FF, (bf16*)(wl + WO_1IN), scr);
            conv_matrix<0>(F, args.in[5] + (size_t)l * FF * D, FF, D, (bf16*)(wl + WO_1OUT), scr);
            conv_matrix<1>(F, args.in[6] + (size_t)l * D * 2 * FF, D, 2 * FF, (bf16*)(wl + WO_2IN), scr);
            conv_matrix<0>(F, args.in[7] + (size_t)l * FF * D, FF, D, (bf16*)(wl + WO_2OUT), scr);
            conv_matrix<0>(F, args.in[8] + (size_t)l * PLE * D, PLE, D, (bf16*)(wl + WO_PROJ), scr);
            conv_matrix<0>(F, args.in[9] + (size_t)l * D * D, D, D, (bf16*)(wl + WO_GATE), scr); }
        conv_matrix<2>(F, args.in[10], D, EVEN_IN, (bf16*)(ws + WS_WEVIN), scr);
        conv_matrix<0>(F, args.in[11], D, D, (bf16*)(ws + WS_WEVOUT), scr);
        conv_matrix<0>(F, args.in[15], D, ODD_IN, (bf16*)(ws + WS_WODIN), scr);
        conv_matrix<0>(F, args.in[16], 2048, D, (bf16*)(ws + WS_WODOUT), scr);
        norm_rows(F, x, norm_g, YN);
        GRID_BAR();
    }
    for (int l = 0; l < DEPTH; ++l) {
        const float* g = norm_g + (size_t)l * 7 * D; unsigned char* wl = ws + WS_WB + l * W_LAYER;
        { pg8::Gemm gm{YN, (const bf16*)(wl + WO_1IN), M, 2 * FF, D}; pg8::StaticOrder S; S.init(M, 2 * FF, F.G, (int)blockIdx.x); pg8::EpiSwiGLU Ep{(bf16*)(BIG + BIG_ACT), FF};
          pg8::gemm_phase<pg8::EpiSwiGLU, pg8::StaticOrder, true, true>(ring, gm, S, Ep); GRID_BAR(); }
        { pg8::Gemm gm{(const bf16*)(BIG + BIG_ACT), (const bf16*)(wl + WO_1OUT), M, D, FF}; pg8::StaticOrder S; S.init(M, D, F.G, (int)blockIdx.x); pg8::EpiStore Ep{YN, D};
          pg8::gemm_phase<pg8::EpiStore, pg8::StaticOrder, true, true>(ring, gm, S, Ep); GRID_BAR(); }
        thin_pass<true, true, false>(F, l == 0 ? x : H, YN, g + 1 * D, 0.5f, H, g + 2 * D, YN, nullptr, nullptr); GRID_BAR();
        if (l == 0) {
            bf16* E = (bf16*)(BIG + BIG_E); bf16* OAB = (bf16*)(BIG + BIG_OAB); float* SCR = (float*)(BIG + BIG_SCR);
            { pg8::Gemm gm{YN, (const bf16*)(ws + WS_WEVIN), M, EVEN_IN, D}; pg8::StaticOrder S; S.init(M, EVEN_IN, F.G, (int)blockIdx.x); pg8::EpiEvenIn Ep{E, positions};
              pg8::gemm_phase<pg8::EpiEvenIn, pg8::StaticOrder, true, true>(ring, gm, S, Ep); GRID_BAR(); }
            naive_hgrn2(F, E, hgrn_lb, SCR); naive_swa(F, E, sinks, OAB); GRID_BAR();
            hgrn_norm(F, SCR, E, hgrn_og, OAB); GRID_BAR();
            { pg8::Gemm gm{OAB, (const bf16*)(ws + WS_WEVOUT), M, D, D}; pg8::StaticOrder S; S.init(M, D, F.G, (int)blockIdx.x); pg8::EpiStore Ep{YN, D};
              pg8::gemm_phase<pg8::EpiStore, pg8::StaticOrder, true, true>(ring, gm, S, Ep); GRID_BAR(); }
        } else {
            bf16* Qb = (bf16*)(BIG + BIG_Q); bf16* Kb = (bf16*)(BIG + BIG_K); bf16* Vb = (bf16*)(BIG + BIG_V); bf16* Gb = (bf16*)(BIG + BIG_G);
            { pg8::Gemm gm{YN, (const bf16*)(ws + WS_WODIN), M, ODD_IN, D}; pg8::StaticOrder S; S.init(M, ODD_IN, F.G, (int)blockIdx.x); pg8::EpiOddIn Ep{Qb, Kb, Vb, Gb, positions, ret_og};
              pg8::gemm_phase<pg8::EpiOddIn, pg8::StaticOrder, true, true>(ring, gm, S, Ep); GRID_BAR(); }
            naive_retention(F, Qb, Kb, Vb, SSQ); GRID_BAR();
            ret_norm(F, Vb, Gb, SSQ); GRID_BAR();
            { pg8::Gemm gm{Vb, (const bf16*)(ws + WS_WODOUT), M, D, 2048}; pg8::StaticOrder S; S.init(M, D, F.G, (int)blockIdx.x); pg8::EpiStore Ep{YN, D};
              pg8::gemm_phase<pg8::EpiStore, pg8::StaticOrder, true, true>(ring, gm, S, Ep); GRID_BAR(); }
        }
        thin_pass<true, true, false>(F, H, YN, g + 3 * D, 1.0f, H, g + 4 * D, YN, nullptr, nullptr); GRID_BAR();
        { pg8::Gemm gm{YN, (const bf16*)(wl + WO_2IN), M, 2 * FF, D}; pg8::StaticOrder S; S.init(M, 2 * FF, F.G, (int)blockIdx.x); pg8::EpiSwiGLU Ep{(bf16*)(BIG + BIG_ACT), FF};
          pg8::gemm_phase<pg8::EpiSwiGLU, pg8::StaticOrder, true, true>(ring, gm, S, Ep); GRID_BAR(); }
        { pg8::Gemm gm{(const bf16*)(BIG + BIG_ACT), (const bf16*)(wl + WO_2OUT), M, D, FF}; pg8::StaticOrder S; S.init(M, D, F.G, (int)blockIdx.x); pg8::EpiStore Ep{YN, D};
          pg8::gemm_phase<pg8::EpiStore, pg8::StaticOrder, true, true>(ring, gm, S, Ep); GRID_BAR(); }
        thin_pass<false, true, true>(F, H, YN, g + 5 * D, 0.5f, H, nullptr, YN, p_in + (size_t)l * M * PLE, (bf16*)(BIG + BIG_PB)); GRID_BAR();
        { pg8::Gemm gm{(const bf16*)(BIG + BIG_PB), (const bf16*)(wl + WO_PROJ), M, D, PLE}; pg8::StaticOrder S; S.init(M, D, F.G, (int)blockIdx.x); pg8::EpiStore Ep{(bf16*)(BIG + BIG_T), D};
          pg8::gemm_phase<pg8::EpiStore, pg8::StaticOrder, true, true>(ring, gm, S, Ep); GRID_BAR(); }
        { pg8::Gemm gm{YN, (const bf16*)(wl + WO_GATE), M, D, D}; pg8::StaticOrder S; S.init(M, D, F.G, (int)blockIdx.x); pg8::EpiPleG Ep{(bf16*)(BIG + BIG_Z), (const bf16*)(BIG + BIG_T)};
          pg8::gemm_phase<pg8::EpiPleG, pg8::StaticOrder, true, true>(ring, gm, S, Ep); GRID_BAR(); }
        if (l == 0) { thin_pass<true, true, false>(F, H, (const bf16*)(BIG + BIG_Z), g + 6 * D, 1.0f, H, norm_g + 7 * D, YN, nullptr, nullptr); GRID_BAR(); }
        else thin_pass<false, false, false>(F, H, (const bf16*)(BIG + BIG_Z), g + 6 * D, 1.0f, H, nullptr, nullptr, nullptr, nullptr);
    }
}

extern "C" void kernel_launch(void* const* d_in, const int* in_sizes, int n_in, void* d_out, int out_size, void* d_ws, size_t ws_size, hipStream_t stream) {
    static int grid = 0;
    if (grid == 0) {
        if (n_in != 18 || in_sizes[0] != M * D || out_size != M * D || ws_size < WS_END) { fprintf(stderr, "kernel_launch: unexpected shapes: n_in %d in0 %d out %d ws %zu (need %zu)\n", n_in, n_in > 0 ? in_sizes[0] : -1, out_size, ws_size, (size_t)WS_END); grid = -1; return; }
        int dev = 0, cus = 0, per_cu = 0;
        if (hipGetDevice(&dev) != hipSuccess || hipDeviceGetAttribute(&cus, hipDeviceAttributeMultiprocessorCount, dev) != hipSuccess) { grid = -1; return; }
        if (hipFuncSetAttribute((const void*)mk_fwd, hipFuncAttributeMaxDynamicSharedMemorySize, LDS_BYTES) != hipSuccess) { fprintf(stderr, "kernel_launch: hipFuncSetAttribute failed\n"); grid = -1; return; }
        if (hipOccupancyMaxActiveBlocksPerMultiprocessor(&per_cu, (const void*)mk_fwd, NWAVES * 64, LDS_BYTES) != hipSuccess || per_cu < 1) { fprintf(stderr, "kernel_launch: occupancy query reports %d\n", per_cu); }
        (void)hipGetLastError();
        grid = cus;
    }
    if (grid < 0) return;
    if (hipMemsetAsync((char*)d_ws + WS_CTL, 0, CTL_ZERO_BYTES, stream) != hipSuccess) return;
    Args a{};
    for (int i = 0; i < 18; ++i) a.in[i] = (const float*)d_in[i];
    a.out = (float*)d_out; a.ws = (unsigned char*)d_ws;
    hipLaunchKernelGGL(mk_fwd, dim3(grid), dim3(NWAVES * 64), LDS_BYTES, stream, a);
}
```

```cpp
#include <hip/hip_runtime.h>
#include <cstdio>
#include <cstdint>
#ifndef PROBE_SKEW
#define PROBE_SKEW 0
#endif
#ifndef PROBE_SKEW_MASK
#define PROBE_SKEW_MASK 0xFFFFFFFFFFFFFFFFull
#endif
#ifndef PROBE_SKEW_AMP
#define PROBE_SKEW_AMP 2
#endif
#ifndef PROBE_EPI2
#define PROBE_EPI2 0
#endif
namespace pg8 {
#define PG8_LAS __attribute__((address_space(3)))
typedef unsigned short bf16_t;
typedef short bf16x8 __attribute__((ext_vector_type(8)));
typedef float f32x4 __attribute__((ext_vector_type(4)));
typedef unsigned u32x4 __attribute__((ext_vector_type(4)));
constexpr int BM = 256, BK = 64, HALF = 128, HTB = HALF * BK * 2  , STAGE_BYTES = 8 * HTB, NXCD = 8, WGM = 8;

__host__ __device__ __forceinline__ int lds_byte(int r, int c) { const int st = (r >> 4) * 2 + (c >> 5), rr = r & 15, cc = c & 31, ob = rr * 64 + cc * 2; return st * 1024 + (ob ^ (((ob >> 9) & 1) << 5)); }
__host__ __device__ __forceinline__ void stage_rc(int b, int& R, int& C) { const int st = b / 1024, sb = b % 1024, swz = sb ^ (((sb >> 9) & 1) << 5); R = (st >> 1) * 16 + swz / 64; C = (st & 1) * 32 + (swz % 64) / 2; }
__host__ __device__ __forceinline__ int perm32(int rho) { const int n = rho >> 4, i = rho & 15; return 8 * (i >> 2) + 4 * n + (i & 3); }

struct Unit { int pm, pn; };
struct Gemm { const bf16_t* A; const bf16_t* Bt; int M, N, K; };

struct StaticOrder {
    int nM, nN, nwg, G, c, wave_id;
    __host__ __device__ void init(int M, int N, int G_, int c_) { nM = M / BM; nN = N / BM; nwg = nM * nN; G = G_; c = c_; }
    __host__ __device__ bool next(int i, Unit& u) const {
        const long L = (long)i * G + c; if (L >= nwg) return false;
        int wgid = (int)L; { const int q = nwg / NXCD, r = nwg % NXCD, xcd = wgid % NXCD, off = wgid / NXCD; wgid = (xcd < r ? xcd * (q + 1) : r * (q + 1) + (xcd - r) * q) + off; }
        const int nig = WGM * nN, gid = wgid / nig, fm = gid * WGM, gsz = (nM - fm) < WGM ? (nM - fm) : WGM;
        u.pm = fm + ((wgid % nig) % gsz); u.pn = (wgid % nig) / gsz; return true;
    }
    __device__ __forceinline__ void a_ready(const Unit&) const {}
    __device__ __forceinline__ void done(const Unit&) const {}
};

__device__ __forceinline__ unsigned cvt_pk_bf16(float lo, float hi) { unsigned r; asm volatile("v_cvt_pk_bf16_f32 %0, %1, %2" : "=v"(r) : "v"(lo), "v"(hi)); return r; }
typedef float f32x2 __attribute__((ext_vector_type(2)));
#ifndef EPI_ADJ
#define EPI_ADJ 1
#endif
#define EPI_COL0(pn, wc, fq) ((pn) * BM + (EPI_ADJ ? (wc) * 64 : (wc) * 32) + 8 * (fq))
#define EPI_BJ (EPI_ADJ ? 32 : HALF)
__device__ __forceinline__ float fsigmoid(float x) { return __builtin_amdgcn_rcpf(1.0f + __builtin_amdgcn_exp2f(-1.4426950408889634f * x)); }
__device__ __forceinline__ float fsilu(float x) { return x * fsigmoid(x); }
__device__ __forceinline__ u32x4 pack8(const f32x4 v0, const f32x4 v1) { u32x4 w; w.x = cvt_pk_bf16(v0[0], v0[1]); w.y = cvt_pk_bf16(v0[2], v0[3]); w.z = cvt_pk_bf16(v1[0], v1[1]); w.w = cvt_pk_bf16(v1[2], v1[3]); return w; }
__device__ __forceinline__ float bflo(unsigned w) { return __uint_as_float(w << 16); }
__device__ __forceinline__ float bfhi(unsigned w) { return __uint_as_float(w & 0xffff0000u); }

struct EpiStore {
    static constexpr bool PERM = true, AFTER_DRAIN = false, HEADSCALE = false;
    bf16_t* O; int ldc;
    __device__ __forceinline__ void operator()(const f32x4 (&acc)[2][2][4][2], const Unit& u, int wr, int wc, int fr, int fq) const {
        const int row0 = u.pm * BM + wr * 64 + fr, col0 = EPI_COL0(u.pn, wc, fq);
#pragma unroll
        for (int ai = 0; ai < 2; ++ai)
#pragma unroll
            for (int m = 0; m < 4; ++m) { bf16_t* rowp = O + (size_t)(row0 + ai * HALF + m * 16) * ldc + col0;
#pragma unroll
                for (int bj = 0; bj < 2; ++bj) *(u32x4*)(rowp + bj * EPI_BJ) = pack8(acc[ai][bj][m][0], acc[ai][bj][m][1]); }
    }
};
struct EpiSwiGLU {
    static constexpr bool PERM = true, AFTER_DRAIN = false, HEADSCALE = false;
    bf16_t* O; int ldc;
    __device__ __forceinline__ void operator()(const f32x4 (&acc)[2][2][4][2], const Unit& u, int wr, int wc, int fr, int fq) const {
        const int row0 = u.pm * BM + wr * 64 + fr, col0 = u.pn * HALF + wc * 32 + 8 * fq;
#pragma unroll
        for (int ai = 0; ai < 2; ++ai)
#pragma unroll
            for (int m = 0; m < 4; ++m) { bf16_t* rowp = O + (size_t)(row0 + ai * HALF + m * 16) * ldc + col0;
                f32x4 r0, r1;
#pragma unroll
                for (int j = 0; j < 4; ++j) {
                    r0[j] = (acc[ai][0][m][0][j] * acc[ai][1][m][0][j]) * __builtin_amdgcn_rcpf(1.0f + __builtin_amdgcn_exp2f(-acc[ai][0][m][0][j]));
                    r1[j] = (acc[ai][0][m][1][j] * acc[ai][1][m][1][j]) * __builtin_amdgcn_rcpf(1.0f + __builtin_amdgcn_exp2f(-acc[ai][0][m][1][j])); }
                __builtin_nontemporal_store(pack8(r0, r1), (u32x4*)rowp); }
    }
};
__device__ __forceinline__ void rope8(const f32x4 (&a0)[2], const f32x4 (&a1)[2], float p, const float (&invf)[2][4], float sc, f32x4 (&o1)[2], f32x4 (&o2)[2]) {
#pragma unroll
    for (int n = 0; n < 2; ++n)
#pragma unroll
        for (int j = 0; j < 4; ++j) { const float rev = __builtin_amdgcn_fractf(p * invf[n][j] * 0.15915494309189535f);
            const float s = __builtin_amdgcn_sinf(rev) * sc, c = __builtin_amdgcn_cosf(rev) * sc; const float x1 = a0[n][j], x2 = a1[n][j];
            o1[n][j] = x1 * c - x2 * s; o2[n][j] = x2 * c + x1 * s; }
}
struct EpiEvenIn {
    static constexpr bool PERM = true, AFTER_DRAIN = false, HEADSCALE = false;
    bf16_t* E; const int* pos;
    __device__ __forceinline__ void operator()(const f32x4 (&acc)[2][2][4][2], const Unit& u, int wr, int wc, int fr, int fq) const {
        const int row0 = u.pm * BM + wr * 64 + fr; constexpr int ldc = 2816;
        if (u.pn < 8 || (u.pn == 10 && wc >= 2)) {
            const int cb = (u.pn < 8) ? u.pn * BM + wc * 32 + 8 * fq : 2688 + 32 * (wc - 2) + 8 * fq; const int cs = (u.pn < 8) ? HALF : 64;
#pragma unroll
            for (int ai = 0; ai < 2; ++ai)
#pragma unroll
                for (int m = 0; m < 4; ++m) { bf16_t* rowp = E + (size_t)(row0 + ai * HALF + m * 16) * ldc + cb;
#pragma unroll
                    for (int bj = 0; bj < 2; ++bj) *(u32x4*)(rowp + bj * cs) = pack8(acc[ai][bj][m][0], acc[ai][bj][m][1]); }
        } else {
            const int cb = ((u.pn < 10) ? 2048 + (u.pn - 8) * BM + 64 * wc : 2560 + 64 * wc) + 8 * fq;
            float invf[2][4];
#pragma unroll
            for (int n = 0; n < 2; ++n)
#pragma unroll
                for (int j = 0; j < 4; ++j) invf[n][j] = __builtin_amdgcn_exp2f(-(float)(8 * fq + 4 * n + j) * (13.287712379549449f / 32.0f));
#pragma unroll
            for (int ai = 0; ai < 2; ++ai)
#pragma unroll
                for (int m = 0; m < 4; ++m) { const int row = row0 + ai * HALF + m * 16; const float p = (float)pos[row]; f32x4 o1[2], o2[2];
                    rope8(acc[ai][0][m], acc[ai][1][m], p, invf, 1.0f, o1, o2);
                    bf16_t* rowp = E + (size_t)row * ldc + cb; *(u32x4*)rowp = pack8(o1[0], o1[1]); *(u32x4*)(rowp + 32) = pack8(o2[0], o2[1]); }
        }
    }
};
struct EpiOddIn {
    static constexpr bool PERM = true, AFTER_DRAIN = false, HEADSCALE = false;
    bf16_t *Q, *K, *V, *G; const int* pos; const float* og;
    __device__ __forceinline__ void operator()(const f32x4 (&acc)[2][2][4][2], const Unit& u, int wr, int wc, int fr, int fq) const {
        const int row0 = u.pm * BM + wr * 64 + fr;
        if (u.pn < 8) {
            bf16_t* dst = (u.pn < 4) ? Q : K; const float sc = (u.pn < 4) ? 1.0f : 0.0625f; const int cb = (u.pn & 3) * BM + 32 * wc + 8 * fq;
            float invf[2][4];
#pragma unroll
            for (int n = 0; n < 2; ++n)
#pragma unroll
                for (int j = 0; j < 4; ++j) invf[n][j] = __builtin_amdgcn_exp2f(-(float)(32 * wc + 8 * fq + 4 * n + j) * (13.287712379549449f / 127.0f));
#pragma unroll
            for (int ai = 0; ai < 2; ++ai)
#pragma unroll
                for (int m = 0; m < 4; ++m) { const int row = row0 + ai * HALF + m * 16; const float p = (float)pos[row]; f32x4 o1[2], o2[2];
                    rope8(acc[ai][0][m], acc[ai][1][m], p, invf, sc, o1, o2);
                    bf16_t* rowp = dst + (size_t)row * 1024 + cb; *(u32x4*)rowp = pack8(o1[0], o1[1]); *(u32x4*)(rowp + HALF) = pack8(o2[0], o2[1]); }
        } else if (u.pn < 16) {
            const int cb = (u.pn - 8) * BM + wc * 32 + 8 * fq;
#pragma unroll
            for (int ai = 0; ai < 2; ++ai)
#pragma unroll
                for (int m = 0; m < 4; ++m) { bf16_t* rowp = V + (size_t)(row0 + ai * HALF + m * 16) * 2048 + cb;
#pragma unroll
                    for (int bj = 0; bj < 2; ++bj) *(u32x4*)(rowp + bj * HALF) = pack8(acc[ai][bj][m][0], acc[ai][bj][m][1]); }
        } else {
            const int cb = (u.pn - 16) * BM + wc * 32 + 8 * fq;
            f32x4 gv[2][2];
#pragma unroll
            for (int bj = 0; bj < 2; ++bj)
#pragma unroll
                for (int n = 0; n < 2; ++n) gv[bj][n] = *(const f32x4*)(og + ((cb + bj * HALF) & 511) + 4 * n);
#pragma unroll
            for (int ai = 0; ai < 2; ++ai)
#pragma unroll
                for (int m = 0; m < 4; ++m) { bf16_t* rowp = G + (size_t)(row0 + ai * HALF + m * 16) * 2048 + cb;
#pragma unroll
                    for (int bj = 0; bj < 2; ++bj) { f32x4 r0, r1;
#pragma unroll
                        for (int j = 0; j < 4; ++j) { r0[j] = fsilu(acc[ai][bj][m][0][j]) * gv[bj][0][j]; r1[j] = fsilu(acc[ai][bj][m][1][j]) * gv[bj][1][j]; }
                        *(u32x4*)(rowp + bj * HALF) = pack8(r0, r1); } }
        }
    }
};
struct EpiPleG {
    static constexpr bool PERM = true, AFTER_DRAIN = false, HEADSCALE = false;
    bf16_t* Z; const bf16_t* T; const float* rsi;
    __device__ __forceinline__ void operator()(const f32x4 (&acc)[2][2][4][2], const Unit& u, int wr, int wc, int fr, int fq) const {
        const int row0 = u.pm * BM + wr * 64 + fr, col0 = EPI_COL0(u.pn, wc, fq);
#pragma unroll
        for (int ai = 0; ai < 2; ++ai)
#pragma unroll
            for (int m = 0; m < 4; ++m) { const size_t off = (size_t)(row0 + ai * HALF + m * 16) * 1024 + col0; const float s = rsi[row0 + ai * HALF + m * 16];
#pragma unroll
                for (int bj = 0; bj < 2; ++bj) { const u32x4 t = *(const u32x4*)(T + off + bj * EPI_BJ); f32x4 r0, r1;
                    r0[0] = fsigmoid(acc[ai][bj][m][0][0] * s) * bflo(t.x); r0[1] = fsigmoid(acc[ai][bj][m][0][1] * s) * bfhi(t.x); r0[2] = fsigmoid(acc[ai][bj][m][0][2] * s) * bflo(t.y); r0[3] = fsigmoid(acc[ai][bj][m][0][3] * s) * bfhi(t.y);
                    r1[0] = fsigmoid(acc[ai][bj][m][1][0] * s) * bflo(t.z); r1[1] = fsigmoid(acc[ai][bj][m][1][1] * s) * bfhi(t.z); r1[2] = fsigmoid(acc[ai][bj][m][1][2] * s) * bflo(t.w); r1[3] = fsigmoid(acc[ai][bj][m][1][3] * s) * bfhi(t.w);
                    *(u32x4*)(Z + off + bj * EPI_BJ) = pack8(r0, r1); } }
    }
};


struct EpiStoreHS {
    static constexpr bool PERM = true, AFTER_DRAIN = false, HEADSCALE = true;
    bf16_t* O; int ldc; const float* ssq;
    __device__ __forceinline__ void rescale(f32x4 (&acc)[2][2][4][2], const Unit& u, int wr, int fr, int hh) const {
        int row0 = u.pm * BM + wr * 64 + fr; asm volatile("" : "+v"(row0));
#pragma unroll
        for (int ai = 0; ai < 2; ++ai)
#pragma unroll
            for (int m = 0; m < 4; ++m) { const float* sp = ssq + (size_t)(row0 + ai * HALF + m * 16) * 4 + hh; const float a = sp[-1] * (1.0f / 512.0f) + 1e-6f, b = sp[0] * (1.0f / 512.0f) + 1e-6f;
                const float ratio = __builtin_amdgcn_sqrtf(b * __builtin_amdgcn_rcpf(a));
#pragma unroll
                for (int bj = 0; bj < 2; ++bj)
#pragma unroll
                    for (int n = 0; n < 2; ++n) acc[ai][bj][m][n] = acc[ai][bj][m][n] * ratio;
                asm volatile("" ::: "memory"); }
    }
    __device__ __forceinline__ void operator()(const f32x4 (&acc)[2][2][4][2], const Unit& u, int wr, int wc, int fr, int fq) const {
        int row0 = u.pm * BM + wr * 64 + fr, col0 = EPI_COL0(u.pn, wc, fq); asm volatile("" : "+v"(row0), "+v"(col0));
#pragma unroll
        for (int ai = 0; ai < 2; ++ai)
#pragma unroll
            for (int m = 0; m < 4; ++m) { const int row = row0 + ai * HALF + m * 16; bf16_t* rowp = O + (size_t)row * ldc + col0; const float s = __builtin_amdgcn_rsqf(ssq[(size_t)row * 4 + 3] * (1.0f / 512.0f) + 1e-6f);
#pragma unroll
                for (int bj = 0; bj < 2; ++bj) *(u32x4*)(rowp + bj * EPI_BJ) = pack8(acc[ai][bj][m][0] * s, acc[ai][bj][m][1] * s);
                asm volatile("" ::: "memory"); }
    }
};
template <class Epi, class Sched, bool ALIGN_EPI = false, bool SP2 = false>
__device__ __forceinline__ void gemm_phase(PG8_LAS unsigned char* lds, const Gemm g, const Sched& S, const Epi& E) {
    unsigned msk_ = ~0u; asm volatile("" : "+s"(msk_)); const int lane = (int)__builtin_amdgcn_mbcnt_hi(msk_, __builtin_amdgcn_mbcnt_lo(msk_, 0u));
    int wid = S.wave_id; asm volatile("" : "+s"(wid)); const int tid = wid * 64 + lane, wr = wid >> 2, wc = wid & 3, fr = lane & 15, fq = lane >> 4;
    const int K = g.K, nt = K / BK;
    unsigned voffA[2], voffB[2];
#pragma unroll
    for (int i = 0; i < 2; ++i) { int R, C; stage_rc(tid * 16 + i * 8192, R, C); const int Rb = Epi::PERM ? ((R & ~31) + perm32(R & 31)) : R;
        voffA[i] = (unsigned)(R * K + C) * 2u; voffB[i] = (unsigned)(Rb * K + C) * 2u; }
    const size_t kstep = (size_t)(BK * 2);
    const size_t hstep = (size_t)HALF * K * 2;
    const size_t tstep = 2 * hstep;
    const unsigned ldsw = (unsigned)wid * 1024u;
    const int aoff = lds_byte(wr * 64 + fr, fq * 8), boff = lds_byte(wc * 32 + fr, fq * 8);
#define PG8_SA(b, h) (((b) * 2 + (h)) * HTB)
#define PG8_SB(b, h) ((4 + (b) * 2 + (h)) * HTB)
#define PG8_STAGE(bufoff, gbase, voff) do { _Pragma("unroll") for (int _i = 0; _i < 2; ++_i) \
        __builtin_amdgcn_global_load_lds((const unsigned*)((const char*)(gbase) + (voff)[_i]), (PG8_LAS unsigned*)(lds + (bufoff) + ldsw + _i * 8192), 16, 0, 0); } while (0)
#define PG8_LDA(dst, b, h) do { _Pragma("unroll") for (int m = 0; m < 4; ++m) _Pragma("unroll") for (int k = 0; k < 2; ++k) dst[m][k] = *(const PG8_LAS bf16x8*)(lds + PG8_SA(b, h) + aoff + m * 2048 + k * 1024); } while (0)
#define PG8_LDB(dst, b, h) do { _Pragma("unroll") for (int n = 0; n < 2; ++n) _Pragma("unroll") for (int k = 0; k < 2; ++k) dst[n][k] = *(const PG8_LAS bf16x8*)(lds + PG8_SB(b, h) + boff + n * 2048 + k * 1024); } while (0)
#define PG8_MMA(ai, bj, At, Bt) do { __builtin_amdgcn_s_setprio(1); _Pragma("unroll") for (int m = 0; m < 4; ++m) _Pragma("unroll") for (int n = 0; n < 2; ++n) _Pragma("unroll") for (int k = 0; k < 2; ++k) \
        acc[ai][bj][m][n] = __builtin_amdgcn_mfma_f32_16x16x32_bf16(Bt[n][k], At[m][k], acc[ai][bj][m][n], 0, 0, 0); __builtin_amdgcn_s_setprio(0); } while (0)
#define PG8_WAIT_V(n) asm volatile("s_waitcnt vmcnt(" #n ")" ::: "memory")
#define PG8_WAIT_L(n) asm volatile("s_waitcnt lgkmcnt(" #n ")" ::: "memory")
#define PG8_BAR __builtin_amdgcn_s_barrier()
#define PG8_SCHED __builtin_amdgcn_sched_barrier(0)
    Unit cur, nxt; int ui = 0;
    if (!S.next(0, cur)) return;
    f32x4 acc[2][2][4][2];
#pragma unroll
    for (int a = 0; a < 2; ++a)
#pragma unroll
        for (int b = 0; b < 2; ++b)
#pragma unroll
            for (int m = 0; m < 4; ++m)
#pragma unroll
                for (int n = 0; n < 2; ++n) acc[a][b][m][n] = (f32x4){0.f, 0.f, 0.f, 0.f};
    bf16x8 At[4][2], B0[2][2], B1[2][2];
    const char* cA = (const char*)g.A + (size_t)cur.pm * tstep; const char* cB = (const char*)g.Bt + (size_t)cur.pn * tstep;
    S.a_ready(cur);
    if constexpr (SP2) {
        PG8_STAGE(PG8_SB(0, 0), cB, voffB); PG8_STAGE(PG8_SB(0, 1), cB + hstep, voffB); PG8_STAGE(PG8_SA(0, 0), cA, voffA); PG8_STAGE(PG8_SA(0, 1), cA + hstep, voffA);
        if (wr == 1) PG8_BAR;
        PG8_WAIT_V(2); PG8_BAR;
        PG8_STAGE(PG8_SB(1, 0), cB + kstep, voffB); PG8_STAGE(PG8_SA(1, 0), cA + kstep, voffA); PG8_STAGE(PG8_SB(1, 1), cB + hstep + kstep, voffB);
        PG8_WAIT_V(6); PG8_BAR;
    } else {
        PG8_STAGE(PG8_SB(0, 0), cB, voffB); PG8_STAGE(PG8_SA(0, 0), cA, voffA); PG8_STAGE(PG8_SB(0, 1), cB + hstep, voffB); PG8_STAGE(PG8_SA(0, 1), cA + hstep, voffA);
        if (wr == 1) PG8_BAR;
        PG8_WAIT_V(4); PG8_BAR;
        PG8_STAGE(PG8_SB(1, 0), cB + kstep, voffB); PG8_STAGE(PG8_SA(1, 0), cA + kstep, voffA); PG8_STAGE(PG8_SB(1, 1), cB + hstep + kstep, voffB);
        PG8_WAIT_V(6); PG8_BAR;
    }
    for (;;) {
        const bool has_next = S.next(ui + 1, nxt);
        const char* nA = has_next ? (const char*)g.A + (size_t)nxt.pm * tstep : cA; const char* nB = has_next ? (const char*)g.Bt + (size_t)nxt.pn * tstep : cB;
        const int tin = Epi::HEADSCALE ? 8 : nt;
        for (int tb = 0; tb < nt; tb += tin) {
        if constexpr (Epi::HEADSCALE) { if (tb != 0) E.rescale(acc, cur, wr, fr, tb >> 3); }
        for (int t = tb; t < tb + tin; t += 2) {
            const bool last = (t == nt - 2);
            const char* a1 = cA + (size_t)(t + 1) * kstep;
            const char* a2 = last ? nA : cA + (size_t)(t + 2) * kstep; const char* b2 = last ? nB : cB + (size_t)(t + 2) * kstep;
            const char* a3 = a2 + kstep; const char* b3 = b2 + kstep;
            if (last && has_next) S.a_ready(nxt);
            if constexpr (SP2) {
            PG8_LDB(B0, 0, 0); PG8_LDB(B1, 0, 1); PG8_SCHED; PG8_LDA(At, 0, 0); PG8_STAGE(PG8_SA(1, 1), a1 + hstep, voffA);
            PG8_WAIT_V(8); PG8_WAIT_L(0); PG8_BAR; PG8_MMA(0, 0, At, B0); PG8_MMA(0, 1, At, B1); PG8_BAR; PG8_SCHED;
            PG8_LDA(At, 0, 1); PG8_STAGE(PG8_SB(0, 0), b2, voffB); PG8_STAGE(PG8_SB(0, 1), b2 + hstep, voffB); PG8_STAGE(PG8_SA(0, 0), a2, voffA);
            PG8_WAIT_V(8); PG8_WAIT_L(0); PG8_BAR; PG8_MMA(1, 0, At, B0); PG8_MMA(1, 1, At, B1); PG8_BAR; PG8_SCHED;
            PG8_LDB(B0, 1, 0); PG8_LDB(B1, 1, 1); PG8_SCHED; PG8_LDA(At, 1, 0); PG8_STAGE(PG8_SA(0, 1), a2 + hstep, voffA);
            PG8_WAIT_V(8); PG8_WAIT_L(0); PG8_BAR; PG8_MMA(0, 0, At, B0); PG8_MMA(0, 1, At, B1); PG8_BAR; PG8_SCHED;
            PG8_LDA(At, 1, 1); PG8_STAGE(PG8_SB(1, 0), b3, voffB); PG8_STAGE(PG8_SB(1, 1), b3 + hstep, voffB); PG8_STAGE(PG8_SA(1, 0), a3, voffA);
            PG8_WAIT_V(8); PG8_WAIT_L(0); PG8_BAR; PG8_MMA(1, 0, At, B0); PG8_MMA(1, 1, At, B1); PG8_BAR; PG8_SCHED;
            } else {
            PG8_LDB(B0, 0, 0); PG8_SCHED; PG8_LDA(At, 0, 0); PG8_STAGE(PG8_SA(1, 1), a1 + hstep, voffA);
            PG8_WAIT_L(8); PG8_BAR; PG8_WAIT_L(0); PG8_MMA(0, 0, At, B0); PG8_BAR; PG8_SCHED;
            PG8_LDB(B1, 0, 1); PG8_STAGE(PG8_SB(0, 0), b2, voffB);
            PG8_BAR; PG8_WAIT_L(0); PG8_MMA(0, 1, At, B1); PG8_BAR;
            PG8_LDA(At, 0, 1); PG8_STAGE(PG8_SA(0, 0), a2, voffA);
            PG8_BAR; PG8_WAIT_L(0); PG8_MMA(1, 0, At, B0); PG8_BAR; PG8_SCHED;
            PG8_STAGE(PG8_SB(0, 1), b2 + hstep, voffB);
            PG8_WAIT_V(6); PG8_BAR; PG8_MMA(1, 1, At, B1); PG8_BAR;
            PG8_LDB(B0, 1, 0); PG8_SCHED; PG8_LDA(At, 1, 0); PG8_STAGE(PG8_SA(0, 1), a2 + hstep, voffA);
            PG8_WAIT_L(8); PG8_BAR; PG8_WAIT_L(0); PG8_MMA(0, 0, At, B0); PG8_BAR; PG8_SCHED;
            PG8_LDB(B1, 1, 1); PG8_STAGE(PG8_SB(1, 0), b3, voffB);
            PG8_BAR; PG8_WAIT_L(0); PG8_MMA(0, 1, At, B1); PG8_BAR;
            PG8_LDA(At, 1, 1); PG8_STAGE(PG8_SA(1, 0), a3, voffA);
            PG8_BAR; PG8_WAIT_L(0); PG8_MMA(1, 0, At, B0); PG8_BAR; PG8_SCHED;
            PG8_STAGE(PG8_SB(1, 1), b3 + hstep, voffB);
            PG8_WAIT_V(6); PG8_BAR; PG8_MMA(1, 1, At, B1); PG8_BAR;
            }
        }
        }
        if constexpr (ALIGN_EPI) { if (wr == 0) PG8_BAR; }
        if constexpr (!Epi::AFTER_DRAIN) { E(acc, cur, wr, wc, fr, fq); if (PROBE_EPI2) { asm volatile("" ::: "memory"); E(acc, cur, wr, wc, fr, fq); } S.done(cur); }
        if (!has_next) break;
#pragma unroll
        for (int a = 0; a < 2; ++a)
#pragma unroll
            for (int b = 0; b < 2; ++b)
#pragma unroll
                for (int m = 0; m < 4; ++m)
#pragma unroll
                    for (int n = 0; n < 2; ++n) acc[a][b][m][n] = (f32x4){0.f, 0.f, 0.f, 0.f};
        cur = nxt; cA = nA; cB = nB; ++ui;
        if constexpr (ALIGN_EPI) { if (wr == 1) PG8_BAR; }
    }
    PG8_WAIT_V(0);
    if constexpr (!ALIGN_EPI) { if (wr == 0) PG8_BAR; }
    PG8_BAR;
    if constexpr (Epi::AFTER_DRAIN) { E.fused(acc, cur, wr, wc, fr, fq, lds, wid, lane); S.done(cur); }
#undef PG8_SA
#undef PG8_SB
#undef PG8_STAGE
#undef PG8_LDA
#undef PG8_LDB
#undef PG8_MMA
#undef PG8_WAIT_V
#undef PG8_WAIT_L
#undef PG8_BAR
#undef PG8_SCHED
}
}

#define GAS __attribute__((address_space(1)))
#define LAS __attribute__((address_space(3)))
typedef unsigned short bf16;
typedef unsigned v4u __attribute__((ext_vector_type(4)));
typedef float f32x4 __attribute__((ext_vector_type(4)));
typedef short bf16x8 __attribute__((ext_vector_type(8)));
typedef GAS unsigned gu32;
typedef GAS unsigned long long gu64;
#define RLX_AGENT __ATOMIC_RELAXED, __HIP_MEMORY_SCOPE_AGENT
#define LDS_WAIT() asm volatile("s_waitcnt lgkmcnt(0)" ::: "memory")
#define VM_WAIT() asm volatile("s_waitcnt vmcnt(0)" ::: "memory")
__device__ __forceinline__ unsigned long long rt() { return __builtin_amdgcn_s_memrealtime(); }
__device__ __forceinline__ unsigned f2bf(float f) { unsigned u = __builtin_bit_cast(unsigned, f); return (u + 0x7fffu + ((u >> 16) & 1u)) >> 16; }
__device__ __forceinline__ unsigned pk2(float lo, float hi) { return f2bf(lo) | (f2bf(hi) << 16); }

#define XB_TMO      128
#define XB_XCNT(j)  (256  + 64 * (j))
#define XB_XSUB(j)  (1280 + 64 * (j))
#define XB_XGEN(j)  (2304 + 64 * (j))
#define XB_TOP      3328
#define XB_TOPGEN   3392
#define XCD_BAR_WORDS 3456
#define XB_SPIN_CAP (1u << 22)

__device__ __forceinline__ unsigned xb_ld(unsigned* p)              { return __hip_atomic_load(p, __ATOMIC_RELAXED, __HIP_MEMORY_SCOPE_AGENT); }
__device__ __forceinline__ unsigned xb_add(unsigned* p, unsigned v) { return __hip_atomic_fetch_add(p, v, __ATOMIC_RELAXED, __HIP_MEMORY_SCOPE_AGENT); }
__device__ __forceinline__ unsigned xb_xcc_id() { return (unsigned)__builtin_amdgcn_s_getreg((3 << 11) | 20) & 0xFu; }
#define XB_SPIN(cond, bar) do { unsigned _sp = 0; while (cond) { __builtin_amdgcn_s_sleep(1); \
    if ((++_sp & 255u) == 0u) { if (xb_ld(&(bar)[XB_TMO])) break; if (_sp > XB_SPIN_CAP) { atomicAdd(&(bar)[XB_TMO], 1u); break; } } } } while (0)

struct XcdBarrier {
    unsigned* bar; unsigned x; int wv;
    volatile LAS unsigned* st;
#if PROBE_SKEW
    unsigned* ts;
#endif
};

__device__ __forceinline__ XcdBarrier xcd_barrier_post(unsigned* bar, volatile LAS unsigned* st) {
    XcdBarrier b; b.bar = bar; b.x = xb_xcc_id(); b.st = st;
    if (threadIdx.x == 0) (void)xb_add(&bar[XB_XCNT(b.x)], 1u);
    return b;
}
__device__ __forceinline__ void xcd_barrier_complete(unsigned* bar, unsigned x, unsigned& nloc, unsigned& nx) {
    const unsigned G = gridDim.x * gridDim.y * gridDim.z;
    unsigned sum, cnt, mine, sp = 0u;
    for (;;) {
        sum = 0u; cnt = 0u; mine = 0u;
#pragma unroll
        for (unsigned j = 0; j < 16; ++j) { const unsigned c = xb_ld(&bar[XB_XCNT(j)]); sum += c; cnt += (c > 0u) ? 1u : 0u; mine = (j == x) ? c : mine; }
        if (sum == G) break;
        __builtin_amdgcn_s_sleep(1);
        if ((++sp & 255u) == 0u) { if (xb_ld(&bar[XB_TMO])) break; if (sp > XB_SPIN_CAP) { atomicAdd(&bar[XB_TMO], 1u); break; } }
    }
    nloc = mine > 0u ? mine : 1u; nx = cnt > 0u ? cnt : 1u;
}

__device__ __forceinline__ void xcd_barrier(const XcdBarrier& b) {
    asm volatile("s_waitcnt vmcnt(0)" ::: "memory");
    __syncthreads();
    unsigned xm_ = ~0u; asm volatile("" : "+s"(xm_));
    if (b.wv == 0 && __builtin_amdgcn_mbcnt_hi(xm_, __builtin_amdgcn_mbcnt_lo(xm_, 0u)) == 0u) {
        unsigned* bar = b.bar; asm volatile("" : "+s"(bar));
#if PROBE_SKEW
        *b.ts = (unsigned)__builtin_amdgcn_s_memrealtime();
#endif
        __builtin_amdgcn_s_waitcnt(0);
        unsigned nloc = b.st[0], nx = b.st[1];
        if (nloc == 0u) { xcd_barrier_complete(bar, b.x, nloc, nx); b.st[0] = nloc; b.st[1] = nx; }
        const unsigned old = xb_add(&bar[XB_XSUB(b.x)], 1u);
        const unsigned gen = old / nloc;
        if (old + 1u == (gen + 1u) * nloc) {
            __builtin_amdgcn_fence(__ATOMIC_RELEASE, "agent");
            asm volatile("s_waitcnt vmcnt(0)" ::: "memory");
            const unsigned og = xb_add(&bar[XB_TOP], 1u);
            const unsigned tg = og / nx;
            if (og + 1u == (tg + 1u) * nx) xb_add(&bar[XB_TOPGEN], 1u);
            else XB_SPIN(xb_ld(&bar[XB_TOPGEN]) == tg, bar);
            __builtin_amdgcn_fence(__ATOMIC_ACQUIRE, "agent");
            xb_add(&bar[XB_XGEN(b.x)], 1u);
            asm volatile("s_waitcnt vmcnt(0)" ::: "memory");
        } else {
            XB_SPIN(xb_ld(&bar[XB_XGEN(b.x)]) == gen, bar);
            __builtin_amdgcn_fence(__ATOMIC_ACQUIRE, "agent");
            asm volatile("s_waitcnt vmcnt(0)" ::: "memory");
        }
    }
    __syncthreads();
}

constexpr int NWAVES = 8;
constexpr int BATCH = 8, SEQ = 8192, D = 1024, FF = 2816, PLE = 256, DEPTH = 2;
constexpr int M = BATCH * SEQ;
constexpr int EVEN_IN = 2816, ODD_IN = 6144;
constexpr float EPS = 1e-6f;
constexpr size_t MiB = 1u << 20;
constexpr size_t WS_CTL = 0, CTL_ZERO_BYTES = 2 * MiB;
constexpr size_t WS_SSQ = 1 * MiB;
constexpr size_t WS_WB = 2 * MiB;
constexpr size_t W_LAYER = 71 * MiB / 2;
constexpr size_t WO_1IN = 0, WO_1OUT = 11 * MiB, WO_2IN = WO_1OUT + 11 * MiB / 2, WO_2OUT = WO_2IN + 11 * MiB, WO_PROJ = WO_2OUT + 11 * MiB / 2, WO_GATE = WO_PROJ + MiB / 2;
static_assert(WO_GATE + 2 * MiB == W_LAYER, "weight map");
constexpr size_t WS_WEVIN = WS_WB + 2 * W_LAYER, WS_WEVOUT = WS_WEVIN + 11 * MiB / 2, WS_WODIN = WS_WEVOUT + 2 * MiB, WS_WODOUT = WS_WODIN + 12 * MiB, WS_WEND = WS_WODOUT + 4 * MiB;
constexpr size_t WS_YN = 98 * MiB;
static_assert(WS_WEND <= WS_YN, "weights fit");
constexpr size_t WS_BIG = WS_YN + 128 * MiB;
constexpr size_t WS_END = WS_BIG + 768 * MiB;
constexpr size_t BIG_ACT = 0, BIG_E = 0, BIG_OAB = 352 * MiB, BIG_SCR = 480 * MiB, BIG_SEGL = 480 * MiB, BIG_SEGD = 496 * MiB;
constexpr size_t BIG_Q = 0, BIG_K = 128 * MiB, BIG_V = 256 * MiB, BIG_G = 512 * MiB;
constexpr size_t BIG_Z = 0, BIG_PB = 352 * MiB, BIG_T = 384 * MiB;
constexpr size_t WS_RS = WS_END;
constexpr size_t WS_NEED = WS_RS + MiB;
constexpr int CW_BAR = 4096;
constexpr int RING_OFF = 0, RING_BYTES = 131072;
constexpr int LDSCTL_OFF = 146944, MISC_OFF = LDSCTL_OFF + 320;
constexpr int LDS_BYTES = 147456;

struct Frame {
    LAS unsigned char* lds;
    int wave, vcu, G;
};
__device__ __forceinline__ int hw_lane() { unsigned m = ~0u; asm volatile("" : "+s"(m)); return (int)__builtin_amdgcn_mbcnt_hi(m, __builtin_amdgcn_mbcnt_lo(m, 0u)); }

__device__ __forceinline__ float wave_sum(float v) {
#pragma unroll
    for (int o = 1; o < 64; o <<= 1) v += __shfl_xor(v, o);
    return v;
}
__device__ __forceinline__ float wave_max(float v) {
#pragma unroll
    for (int o = 1; o < 64; o <<= 1) v = fmaxf(v, __shfl_xor(v, o));
    return v;
}
__device__ __forceinline__ float bf2f(bf16 b) { return __uint_as_float(((unsigned)b) << 16); }
__device__ __forceinline__ float blo(unsigned w) { return __uint_as_float(w << 16); }
__device__ __forceinline__ float bhi(unsigned w) { return __uint_as_float(w & 0xffff0000u); }
__device__ __forceinline__ float fsig(float x) { return 1.0f / (1.0f + __expf(-x)); }
__device__ __forceinline__ float fsg(float x) { return __builtin_amdgcn_rcpf(1.0f + __builtin_amdgcn_exp2f(-1.4426950408889634f * x)); }
__device__ __forceinline__ void unpack8(const v4u w, float (&f)[8]) { f[0] = blo(w.x); f[1] = bhi(w.x); f[2] = blo(w.y); f[3] = bhi(w.y); f[4] = blo(w.z); f[5] = bhi(w.z); f[6] = blo(w.w); f[7] = bhi(w.w); }
__device__ __forceinline__ v4u pack8f(const float (&f)[8]) { v4u w; w.x = pk2(f[0], f[1]); w.y = pk2(f[2], f[3]); w.z = pk2(f[4], f[5]); w.w = pk2(f[6], f[7]); return w; }

__device__ __forceinline__ void transpose_item(const float* W, int K, int Nsrc, bf16* WT, int dr0, int sc0, int k0, LAS float* scr, int lane, const float* gk, float cs) {
    const float gv = (gk ? gk[k0 + lane] : 1.0f) * cs;
    float wv[32];
#pragma unroll
    for (int i = 0; i < 32; ++i) wv[i] = W[(size_t)(k0 + 2 * i + (lane >> 5)) * Nsrc + sc0 + (lane & 31)];
#pragma unroll
    for (int i = 0; i < 32; ++i) { const int kk = 2 * i + (lane >> 5); scr[kk * 33 + (lane & 31)] = wv[i] * __shfl(gv, kk); }
    LDS_WAIT(); asm volatile("" ::: "memory");
    const int c = lane & 7;
#pragma unroll
    for (int j = 0; j < 4; ++j) { const int n = (lane >> 3) + 8 * j; const LAS float* s = scr + (8 * c) * 33 + n;
        v4u o; o.x = pk2(s[0 * 33], s[1 * 33]); o.y = pk2(s[2 * 33], s[3 * 33]); o.z = pk2(s[4 * 33], s[5 * 33]); o.w = pk2(s[6 * 33], s[7 * 33]);
        *(GAS v4u*)(WT + (size_t)(dr0 + n) * K + k0 + 8 * c) = o; }
    LDS_WAIT(); asm volatile("" ::: "memory");
}
__device__ __forceinline__ int ffn_src_col(int n0) { const int pn = n0 >> 8, bj = (n0 >> 7) & 1, w = n0 & 127; return bj * FF + 128 * pn + w; }
__device__ __forceinline__ int adj_src_col(int n0) { return EPI_ADJ ? (n0 & ~255) + 64 * ((n0 >> 5) & 3) + 32 * ((n0 >> 7) & 1) : n0; }
__device__ __forceinline__ int even_src_col(int n0) {
    const int pn = n0 >> 8; if (pn < 8) return n0;
    const int bj = (n0 >> 7) & 1, wc = (n0 >> 5) & 3;
    if (pn < 10) return 256 * pn + 64 * wc + 32 * bj;
    if (wc < 2) return 2560 + 64 * wc + 32 * bj;
    return 2688 + 64 * bj + 32 * (wc - 2);
}
#ifndef PROBE_P0WG
#define PROBE_P0WG 0
#endif
#ifndef PROBE_P0SEL
#define PROBE_P0SEL 0
#endif
#ifndef P0_PAIR
#define P0_PAIR 0
#endif
#ifndef P0_BAL
#define P0_BAL 1
#endif
template <int MAP> __device__ __forceinline__ void conv_matrix(Frame& F, const float* W, int K, int N, bf16* WT, LAS float* scr, int& base, const float* gk = nullptr) {
    int lane = hw_lane();
    int gw = F.vcu * NWAVES + F.wave, NGW = F.G * NWAVES; asm volatile("" : "+s"(gw), "+s"(NGW)); const int nblk = N / 32, nitems = (K / 64) * nblk;
    int it0 = gw - (P0_BAL ? base : 0); if (it0 < 0) it0 += NGW; base = (base + nitems) % NGW;
    for (int it = it0; it < nitems; it += NGW) { const int kb = it / nblk, nb = it % nblk, n0 = 32 * nb;
        const int sc0 = MAP == 0 ? n0 : (MAP == 1 ? ffn_src_col(n0) : (MAP == 2 ? even_src_col(n0) : adj_src_col(n0)));
        const float cs = MAP == 1 ? (((n0 >> 7) & 1) ? 0.6931471805599453f : 1.4426950408889634f) : 1.0f;
        transpose_item(W, K, N, WT, n0, sc0, 64 * kb, scr, lane, gk, cs); }
}
template <int MAP> __device__ __forceinline__ void conv_item_cols(int n0, int& sc0, float& cs) {
    sc0 = MAP == 0 ? n0 : (MAP == 1 ? ffn_src_col(n0) : even_src_col(n0)); cs = MAP == 1 ? (((n0 >> 7) & 1) ? 0.6931471805599453f : 1.4426950408889634f) : 1.0f; }
__device__ __forceinline__ void conv_finish(const float (&wv)[32], float gv, bf16* WT, int K, int dr0, int k0, LAS float* scr, int lane) {
#pragma unroll
    for (int i = 0; i < 32; ++i) { const int kk = 2 * i + (lane >> 5); scr[kk * 33 + (lane & 31)] = wv[i] * __shfl(gv, kk); }
    LDS_WAIT(); asm volatile("" ::: "memory");
    const int c = lane & 7;
#pragma unroll
    for (int j = 0; j < 4; ++j) { const int n = (lane >> 3) + 8 * j; const LAS float* s = scr + (8 * c) * 33 + n;
        v4u o; o.x = pk2(s[0 * 33], s[1 * 33]); o.y = pk2(s[2 * 33], s[3 * 33]); o.z = pk2(s[4 * 33], s[5 * 33]); o.w = pk2(s[6 * 33], s[7 * 33]);
        *(GAS v4u*)(WT + (size_t)(dr0 + n) * K + k0 + 8 * c) = o; }
    LDS_WAIT(); asm volatile("" ::: "memory");
}
template <int MAPA, int MAPB> __device__ __forceinline__ void conv_pair(Frame& F, const float* WA, int KA, int NA, bf16* TA, const float* gA, const float* WB, int KB, int NB, bf16* TB, const float* gB, LAS float* scr, int& base) {
    int lane = hw_lane();
    int gw = F.vcu * NWAVES + F.wave, NGW = F.G * NWAVES; asm volatile("" : "+s"(gw), "+s"(NGW));
    const int nblkA = NA / 32, nitA = (KA / 64) * nblkA, nblkB = NB / 32, nitB = (KB / 64) * nblkB;
    int ia = gw - base; if (ia < 0) ia += NGW; base = (base + nitA) % NGW;
    int ib = gw - base; if (ib < 0) ib += NGW; base = (base + nitB) % NGW;
    for (; ia < nitA || ib < nitB; ia += NGW, ib += NGW) {
        const bool onA = ia < nitA, onB = ib < nitB;
        float wa[32], wb[32], gva = 1.0f, gvb = 1.0f; int scA = 0, scB = 0, k0A = 0, k0B = 0, n0A = 0, n0B = 0; float csA = 1.0f, csB = 1.0f;
        if (onA) { const int kb = ia / nblkA, nb = ia % nblkA; n0A = 32 * nb; k0A = 64 * kb; conv_item_cols<MAPA>(n0A, scA, csA); gva = (gA ? gA[k0A + lane] : 1.0f) * csA;
#pragma unroll
            for (int i = 0; i < 32; ++i) wa[i] = WA[(size_t)(k0A + 2 * i + (lane >> 5)) * NA + scA + (lane & 31)]; }
        if (onB) { const int kb = ib / nblkB, nb = ib % nblkB; n0B = 32 * nb; k0B = 64 * kb; conv_item_cols<MAPB>(n0B, scB, csB); gvb = (gB ? gB[k0B + lane] : 1.0f) * csB;
#pragma unroll
            for (int i = 0; i < 32; ++i) wb[i] = WB[(size_t)(k0B + 2 * i + (lane >> 5)) * NB + scB + (lane & 31)]; }
        if (onA) conv_finish(wa, gva, TA, KA, n0A, k0A, scr, lane);
        if (onB) conv_finish(wb, gvb, TB, KB, n0B, k0B, scr, lane);
    }
}

__device__ __forceinline__ void load_g16(const float* g, int lane, float (&o)[16]) {
#pragma unroll
    for (int j = 0; j < 2; ++j) { const f32x4 a = *(const f32x4*)(g + 8 * lane + 512 * j), b = *(const f32x4*)(g + 8 * lane + 512 * j + 4);
        o[8 * j + 0] = a.x; o[8 * j + 1] = a.y; o[8 * j + 2] = a.z; o[8 * j + 3] = a.w; o[8 * j + 4] = b.x; o[8 * j + 5] = b.y; o[8 * j + 6] = b.z; o[8 * j + 7] = b.w; }
}
__device__ __forceinline__ void load_h16(const float* hrow, int lane, float (&o)[16]) { load_g16(hrow, lane, o); }
__device__ __forceinline__ void store_h16(float* hrow, int lane, const float (&o)[16]) {
#pragma unroll
    for (int j = 0; j < 2; ++j) { *(f32x4*)(hrow + 8 * lane + 512 * j) = (f32x4){o[8 * j], o[8 * j + 1], o[8 * j + 2], o[8 * j + 3]}; *(f32x4*)(hrow + 8 * lane + 512 * j + 4) = (f32x4){o[8 * j + 4], o[8 * j + 5], o[8 * j + 6], o[8 * j + 7]}; }
}
__device__ __forceinline__ void store_b16(bf16* row, int lane, const float (&o)[16]) {
#pragma unroll
    for (int j = 0; j < 2; ++j) { v4u w; w.x = pk2(o[8 * j], o[8 * j + 1]); w.y = pk2(o[8 * j + 2], o[8 * j + 3]); w.z = pk2(o[8 * j + 4], o[8 * j + 5]); w.w = pk2(o[8 * j + 6], o[8 * j + 7]); *(v4u*)(row + 8 * lane + 512 * j) = w; }
}
#ifndef INIT_PF
#define INIT_PF 0
#endif
__device__ __forceinline__ void init_rows(Frame& F, const float* x, bf16* HB, float* RS) {
    int lane = hw_lane();
    int gw = F.vcu * NWAVES + F.wave, NGW = F.G * NWAVES; asm volatile("" : "+s"(gw), "+s"(NGW));
    float hn[16]; if (INIT_PF && gw < M) load_h16(x + (size_t)gw * D, lane, hn);
    for (int m = gw; m < M; m += NGW) { float h[16];
        if (INIT_PF) {
#pragma unroll
            for (int i = 0; i < 16; ++i) h[i] = hn[i];
            const int mn = m + NGW < M ? m + NGW : m; load_h16(x + (size_t)mn * D, lane, hn);
        } else load_h16(x + (size_t)m * D, lane, h);
        float s = 0.f;
#pragma unroll
        for (int i = 0; i < 16; ++i) s += h[i] * h[i];
        s = wave_sum(s) * (1.0f / D) + EPS; const float rstd = rsqrtf(s);
#pragma unroll
        for (int i = 0; i < 16; ++i) h[i] *= rstd;
        store_b16(HB + (size_t)m * D, lane, h);
        if (lane == 0) RS[m] = s * rstd; }
}
#ifndef THIN_NT
#define THIN_NT 3
#endif
#define THIN_LDY(p) ((THIN_NT & 1) ? __builtin_nontemporal_load((const v4u*)(p)) : *(const v4u*)(p))
__device__ __forceinline__ void store_h16_nt(float* hrow, int lane, const float (&o)[16]) {
#pragma unroll
    for (int j = 0; j < 2; ++j) { __builtin_nontemporal_store((f32x4){o[8 * j], o[8 * j + 1], o[8 * j + 2], o[8 * j + 3]}, (f32x4*)(hrow + 8 * lane + 512 * j)); __builtin_nontemporal_store((f32x4){o[8 * j + 4], o[8 * j + 5], o[8 * j + 6], o[8 * j + 7]}, (f32x4*)(hrow + 8 * lane + 512 * j + 4)); }
}
template <bool FINAL, bool CONV_P>
__device__ __forceinline__ void thin_pass(Frame& F, bf16* HB, const bf16* Y, const float* gA, float c, float* RS, float* outf, const float* psrc, bf16* PBo, bf16* HBo = nullptr) {
    int lane = hw_lane();
    int gw = F.vcu * NWAVES + F.wave, NGW = F.G * NWAVES; asm volatile("" : "+s"(gw), "+s"(NGW));
    float ga[16]; load_g16(gA, lane, ga);
    v4u yw[2], hw[2], yn[2], hn[2]; f32x4 pv, pn;
#pragma unroll
    for (int j = 0; j < 2; ++j) { yw[j] = THIN_LDY(Y + (size_t)gw * D + 8 * lane + 512 * j); hw[j] = *(const v4u*)(HB + (size_t)gw * D + 8 * lane + 512 * j); }
    if (CONV_P) pv = *(const f32x4*)(psrc + (size_t)gw * PLE + 4 * lane);
    float rcur = RS[gw];
    for (int m = gw; m < M; m += NGW) {
        const int mn = (m + NGW < M) ? m + NGW : m;
        const float rnext = RS[mn];
#pragma unroll
        for (int j = 0; j < 2; ++j) { yn[j] = THIN_LDY(Y + (size_t)mn * D + 8 * lane + 512 * j); hn[j] = *(const v4u*)(HB + (size_t)mn * D + 8 * lane + 512 * j); }
        if (CONV_P) pn = *(const f32x4*)(psrc + (size_t)mn * PLE + 4 * lane);
        float y[16], h[16];
#pragma unroll
        for (int j = 0; j < 2; ++j) { const v4u w = yw[j]; const v4u hh = hw[j];
            y[8 * j + 0] = blo(w.x); y[8 * j + 1] = bhi(w.x); y[8 * j + 2] = blo(w.y); y[8 * j + 3] = bhi(w.y); y[8 * j + 4] = blo(w.z); y[8 * j + 5] = bhi(w.z); y[8 * j + 6] = blo(w.w); y[8 * j + 7] = bhi(w.w);
            h[8 * j + 0] = blo(hh.x); h[8 * j + 1] = bhi(hh.x); h[8 * j + 2] = blo(hh.y); h[8 * j + 3] = bhi(hh.y); h[8 * j + 4] = blo(hh.z); h[8 * j + 5] = bhi(hh.z); h[8 * j + 6] = blo(hh.w); h[8 * j + 7] = bhi(hh.w); }
        float s = 0.f;
#pragma unroll
        for (int i = 0; i < 16; ++i) s += y[i] * y[i];
        const float rstd = rsqrtf(wave_sum(s) * (1.0f / D) + EPS) * c;
#pragma unroll
        for (int i = 0; i < 16; ++i) h[i] = h[i] * rcur + y[i] * rstd * ga[i];
        rcur = rnext;
        if (FINAL) { if (THIN_NT & 2) store_h16_nt(outf + (size_t)m * D, lane, h); else store_h16(outf + (size_t)m * D, lane, h); }
        else { float s2 = 0.f;
#pragma unroll
            for (int i = 0; i < 16; ++i) s2 += h[i] * h[i];
            s2 = wave_sum(s2) * (1.0f / D) + EPS; const float r2 = rsqrtf(s2);
#pragma unroll
            for (int i = 0; i < 16; ++i) h[i] *= r2;
            store_b16((HBo ? HBo : HB) + (size_t)m * D, lane, h);
            if (lane == 0 && !HBo) RS[m] = s2 * r2; }
        if (CONV_P) { *(unsigned long long*)(PBo + (size_t)m * PLE + 4 * lane) = (unsigned long long)pk2(pv.x, pv.y) | ((unsigned long long)pk2(pv.z, pv.w) << 32); pv = pn; }
#pragma unroll
        for (int j = 0; j < 2; ++j) { yw[j] = yn[j]; hw[j] = hn[j]; }
    }
}

__device__ __forceinline__ void naive_hgrn2(Frame& F, const bf16* E, const float* hgrn_lb, float* SCR) {
    int lane = hw_lane(); int gw = F.vcu * NWAVES + F.wave, NGW = F.G * NWAVES; asm volatile("" : "+s"(gw), "+s"(NGW)); const int gw_unused_ = 0;
    for (int unit = gw; unit < 256; unit += NGW) {
        const int b = unit >> 5, h = (unit >> 3) & 3, vg = unit & 7;
        const float lb0 = fsig(hgrn_lb[h * 128 + lane] - hgrn_lb[512 + h * 128 + lane]), lb1 = fsig(hgrn_lb[h * 128 + 64 + lane] - hgrn_lb[512 + h * 128 + 64 + lane]);
        float s0[16], s1[16];
#pragma unroll
        for (int j = 0; j < 16; ++j) { s0[j] = 0.f; s1[j] = 0.f; }
        const bf16* e = E + (size_t)b * SEQ * EVEN_IN; float* so = SCR + (size_t)b * SEQ * 512 + h * 128 + vg * 16;
        for (int t = 0; t < SEQ; ++t, e += EVEN_IN, so += 512) {
            float q0 = bf2f(e[h * 128 + lane]), q1 = bf2f(e[h * 128 + 64 + lane]);
            const float fl0 = bf2f(e[512 + h * 128 + lane]), fl1 = bf2f(e[512 + h * 128 + 64 + lane]);
            q0 = q0 * fsig(q0); q1 = q1 * fsig(q1);
            const float f0 = lb0 + (1.0f - lb0) * fsig(fl0), f1 = lb1 + (1.0f - lb1) * fsig(fl1), k0 = 1.0f - f0, k1 = 1.0f - f1;
            float v[16]; { float t8[8]; unpack8(*(const v4u*)(e + 1024 + h * 128 + vg * 16), t8);
#pragma unroll
                for (int j = 0; j < 8; ++j) v[j] = t8[j];
                unpack8(*(const v4u*)(e + 1024 + h * 128 + vg * 16 + 8), t8);
#pragma unroll
                for (int j = 0; j < 8; ++j) v[8 + j] = t8[j]; }
            float myo = 0.f;
#pragma unroll
            for (int j = 0; j < 16; ++j) { s0[j] = f0 * s0[j] + k0 * v[j]; s1[j] = f1 * s1[j] + k1 * v[j]; const float o = wave_sum(q0 * s0[j] + q1 * s1[j]); if (lane == j) myo = o; }
            if (lane < 16) so[lane] = myo;
        }
    }
}
__device__ __forceinline__ void hgrn_norm(Frame& F, const float* SCR, const bf16* E, const float* og, bf16* OAB) {
    int lane = hw_lane(); int gw = F.vcu * NWAVES + F.wave, NGW = F.G * NWAVES; asm volatile("" : "+s"(gw), "+s"(NGW)); const int gw_unused_ = 0;
    const float g0 = og[lane], g1 = og[64 + lane];
    for (int u = gw; u < M * 4; u += NGW) { const int row = u >> 2, h = u & 3;
        const float o0 = SCR[(size_t)row * 512 + h * 128 + lane], o1 = SCR[(size_t)row * 512 + h * 128 + 64 + lane];
        const float rstd = rsqrtf(wave_sum(o0 * o0 + o1 * o1) * (1.0f / 128.0f) + EPS);
        const float a0 = bf2f(E[(size_t)row * EVEN_IN + 1536 + h * 128 + lane]), a1 = bf2f(E[(size_t)row * EVEN_IN + 1536 + h * 128 + 64 + lane]);
        OAB[(size_t)row * D + h * 128 + lane] = (bf16)f2bf(o0 * rstd * g0 * a0 * fsig(a0)); OAB[(size_t)row * D + h * 128 + 64 + lane] = (bf16)f2bf(o1 * rstd * g1 * a1 * fsig(a1)); }
}
__device__ __forceinline__ void naive_swa(Frame& F, const bf16* E, const float* sinks, bf16* OAB) {
    int lane = hw_lane(); int gw = F.vcu * NWAVES + F.wave, NGW = F.G * NWAVES; asm volatile("" : "+s"(gw), "+s"(NGW)); const int gw_unused_ = 0;
    for (int unit = gw; unit < M * 8; unit += NGW) {
        const int row = unit >> 3, hq = unit & 7, g = hq >> 2, t = row & (SEQ - 1);
        float q[64];
#pragma unroll
        for (int i = 0; i < 8; ++i) { float t8[8]; unpack8(*(const v4u*)(E + (size_t)row * EVEN_IN + 2048 + hq * 64 + 8 * i), t8);
#pragma unroll
            for (int j = 0; j < 8; ++j) q[8 * i + j] = t8[j]; }
        float sc[2];
#pragma unroll
        for (int kk = 0; kk < 2; ++kk) { const int jt = t - 127 + lane + 64 * kk; const bool valid = jt >= 0; const int jr = valid ? jt : 0;
            const bf16* kp = E + (size_t)(row - t + jr) * EVEN_IN + 2560 + g * 64; float dot = 0.f;
#pragma unroll
            for (int i = 0; i < 8; ++i) { float t8[8]; unpack8(*(const v4u*)(kp + 8 * i), t8);
#pragma unroll
                for (int j = 0; j < 8; ++j) dot += q[8 * i + j] * t8[j]; }
            sc[kk] = valid ? dot * 0.125f : -__builtin_inff(); }
        const float sink = sinks[hq];
        const float mx = fmaxf(wave_max(fmaxf(sc[0], sc[1])), sink);
        const float p0 = __expf(sc[0] - mx), p1 = __expf(sc[1] - mx);
        const float denom = wave_sum(p0 + p1) + __expf(sink - mx);
        float o = 0.f;
        for (int j = 0; j < 128; ++j) { const int jt = t - 127 + j; const float pj = __shfl(j < 64 ? p0 : p1, j & 63);
            if (jt >= 0) o += pj * bf2f(E[(size_t)(row - t + jt) * EVEN_IN + 2688 + g * 64 + lane]); }
        OAB[(size_t)row * D + 512 + hq * 64 + lane] = (bf16)f2bf(o / denom);
    }
}
__device__ __forceinline__ void naive_retention(Frame& F, const bf16* Q, const bf16* K, bf16* V, float* SSQ) {
    int lane = hw_lane(); int gw = F.vcu * NWAVES + F.wave, NGW = F.G * NWAVES; asm volatile("" : "+s"(gw), "+s"(NGW)); const int gw_unused_ = 0;
    for (int unit = gw; unit < 2048; unit += NGW) {
        const int b = unit >> 8, h = (unit >> 6) & 3, v8 = unit & 63;
        const float gamma = 1.0f - exp2f(-5.0f - (float)h);
        float s[4][8];
#pragma unroll
        for (int i = 0; i < 4; ++i)
#pragma unroll
            for (int j = 0; j < 8; ++j) s[i][j] = 0.f;
        for (int t = 0; t < SEQ; ++t) { const size_t row = (size_t)b * SEQ + t;
            float q[4], k[4];
#pragma unroll
            for (int i = 0; i < 4; ++i) { q[i] = bf2f(Q[row * 1024 + h * 256 + lane + 64 * i]); k[i] = bf2f(K[row * 1024 + h * 256 + lane + 64 * i]); }
            float v[8]; unpack8(*(const v4u*)(V + row * 2048 + h * 512 + v8 * 8), v);
            float o[8]; float ss = 0.f;
#pragma unroll
            for (int j = 0; j < 8; ++j) { float a = 0.f;
#pragma unroll
                for (int i = 0; i < 4; ++i) { s[i][j] = gamma * s[i][j] + k[i] * v[j]; a += q[i] * s[i][j]; }
                o[j] = wave_sum(a); ss += o[j] * o[j]; }
            if (lane == 0) { *(v4u*)(V + row * 2048 + h * 512 + v8 * 8) = pack8f(o); atomicAdd(SSQ + row * 4 + h, ss); }
        }
    }
}
template <bool DRY> __device__ __forceinline__ void ret_norm(Frame& F, bf16* V, const bf16* G, const float* SSQ) {
    int lane = hw_lane(); int gw = F.vcu * NWAVES + F.wave, NGW = F.G * NWAVES; asm volatile("" : "+s"(gw), "+s"(NGW)); const int gw_unused_ = 0;
    for (int m = gw; m < M; m += NGW) {
#pragma unroll
        for (int j = 0; j < 4; ++j) { const float rstd = rsqrtf(SSQ[(size_t)m * 4 + j] * (1.0f / 512.0f) + EPS);
            float o[8], g[8]; unpack8(*(const v4u*)(V + (size_t)m * 2048 + 512 * j + 8 * lane), o); unpack8(*(const v4u*)(G + (size_t)m * 2048 + 512 * j + 8 * lane), g);
#pragma unroll
            for (int i = 0; i < 8; ++i) o[i] = o[i] * rstd * g[i];
            if (!DRY) *(v4u*)(V + (size_t)m * 2048 + 512 * j + 8 * lane) = pack8f(o); else { const v4u t_ = pack8f(o); asm volatile("" :: "v"(t_.x), "v"(t_.y), "v"(t_.z), "v"(t_.w)); } }
    }
}

typedef short s16x4 __attribute__((ext_vector_type(4)));
typedef float f32x2_t __attribute__((ext_vector_type(2))); typedef __bf16 bf16x2_t __attribute__((ext_vector_type(2)));
typedef unsigned v2u __attribute__((ext_vector_type(2)));
__device__ __forceinline__ unsigned cvtpk(float lo, float hi) { f32x2_t v = {lo, hi}; bf16x2_t b = __builtin_convertvector(v, bf16x2_t); return __builtin_bit_cast(unsigned, b); }
__device__ __forceinline__ s16x4 vtr(const LAS unsigned char* p) { return __builtin_bit_cast(s16x4, __builtin_amdgcn_ds_read_tr16_b64_v4i16((LAS s16x4*)p)); }
__device__ __forceinline__ bf16x8 trpair(const LAS unsigned char* p0, const LAS unsigned char* p1) { const s16x4 a = vtr(p0), b = vtr(p1); return (bf16x8){a[0], a[1], a[2], a[3], b[0], b[1], b[2], b[3]}; }
__device__ __forceinline__ bf16x8 pack_acc2(const f32x4 a, const f32x4 b) { v4u w; w.x = cvtpk(a[0], a[1]); w.y = cvtpk(a[2], a[3]); w.z = cvtpk(b[0], b[1]); w.w = cvtpk(b[2], b[3]); return __builtin_bit_cast(bf16x8, w); }
#define MFMA16(a, b, c) __builtin_amdgcn_mfma_f32_16x16x32_bf16((a), (b), (c), 0, 0, 0)
#define LBAR() do { asm volatile("s_waitcnt lgkmcnt(0)" ::: "memory"); __builtin_amdgcn_s_barrier(); asm volatile("" ::: "memory"); } while (0)

constexpr int R_KS = 528, R_VS = 144;
#ifndef RET_KSTG
#define RET_KSTG 1
#endif
constexpr int R_KT = 0, R_KSTG = 128 * R_KS;
static_assert(R_KSTG + 8 * 32 * 272 <= 146944, "R0 LDS map");
constexpr int R_VT0 = 0, R_VT1 = 128 * R_VS, R_ST0 = 2 * 128 * R_VS, R_ST1 = R_ST0 + 64 * R_KS, R_END = R_ST1 + 64 * R_KS, R_PK = R_END;
__device__ __forceinline__ void ret_att_phase(Frame& F, const bf16* Q, const bf16* K, bf16x8* ATT, bf16* KDT) {
    int w = F.wave; asm volatile("" : "+s"(w)); const int lane = hw_lane(), tid = w * 64 + lane, g = lane >> 4, r16 = lane & 15, q4 = r16 >> 2, p4 = r16 & 3;
    LAS unsigned char* const lds = F.lds;
    const int ct = w < 4 ? w : 11 - w;
    for (int unit = F.vcu; unit < 2048; unit += F.G) {
        const int bh = unit >> 6, n = unit & 63, b = bh >> 2, h = bh & 3;
        const float lg2 = __builtin_log2f(1.0f - __builtin_amdgcn_exp2f(-5.0f - (float)h));
        const size_t r0 = (size_t)b * SEQ + (size_t)n * 128;
        const bf16* Kg = K + (r0 + (tid >> 5)) * 1024 + h * 256 + (tid & 31) * 8;
        v4u Kr[8]; bf16x8 Qf[8];
#pragma unroll
        for (int i = 0; i < 8; ++i) Kr[i] = *(const v4u*)(Kg + (size_t)i * 16 * 1024);
#pragma unroll
        for (int ks = 0; ks < 8; ++ks) Qf[ks] = *(const bf16x8*)(Q + (r0 + 16 * ct + r16) * 1024 + h * 256 + 8 * g + 32 * ks);
        LBAR();
#pragma unroll
        for (int i = 0; i < 8; ++i) *(LAS v4u*)(lds + R_KT + ((tid >> 5) + 16 * i) * R_KS + (tid & 31) * 16) = Kr[i];
        LBAR();
        f32x4 at[8];
#pragma unroll
        for (int st = 0; st < 8; ++st) { at[st] = (f32x4){0.f, 0.f, 0.f, 0.f};
            if (st <= ct) {
#pragma unroll
                for (int ks = 0; ks < 8; ++ks) { const bf16x8 a = *(const LAS bf16x8*)(lds + R_KT + (16 * st + r16) * R_KS + (32 * ks + 8 * g) * 2); at[st] = MFMA16(a, Qf[ks], at[st]); }
#pragma unroll
                for (int r = 0; r < 4; ++r) { const int d = 16 * ct + r16 - (16 * st + 4 * g + r); at[st][r] = d >= 0 ? at[st][r] * __builtin_amdgcn_exp2f((float)d * lg2) : 0.f; }
            } }
#pragma unroll
        for (int sp = 0; sp < 4; ++sp) if (2 * sp <= ct) ATT[(((size_t)unit * 8 + ct) * 4 + sp) * 64 + lane] = pack_acc2(at[2 * sp], at[2 * sp + 1]);
        bf16* Ko = KDT + (size_t)unit * 256 * 128;
#pragma unroll
        for (int kt = 0; kt < 2; ++kt)
#pragma unroll
            for (int sb = 0; sb < 8; ++sb) { const int s0 = 16 * sb + 4 * g;
                const s16x4 t4 = vtr(lds + R_KT + (s0 + q4) * R_KS + (32 * w + 16 * kt + 4 * p4) * 2);
                float f0 = bf2f((bf16)t4[0]) * __builtin_amdgcn_exp2f((float)(127 - s0) * lg2), f1 = bf2f((bf16)t4[1]) * __builtin_amdgcn_exp2f((float)(126 - s0) * lg2);
                float f2 = bf2f((bf16)t4[2]) * __builtin_amdgcn_exp2f((float)(125 - s0) * lg2), f3 = bf2f((bf16)t4[3]) * __builtin_amdgcn_exp2f((float)(124 - s0) * lg2);
                v2u o2; o2.x = cvtpk(f0, f1); o2.y = cvtpk(f2, f3);
                if (RET_KSTG) *(LAS v2u*)(lds + R_KSTG + w * (32 * 272) + (16 * kt + r16) * 272 + s0 * 2) = o2;
                else *(v2u*)(Ko + (size_t)(32 * w + 16 * kt + r16) * 128 + s0) = o2; }
        if (RET_KSTG) {
#pragma unroll
            for (int i = 0; i < 8; ++i) { const int o = (i * 64 + lane) * 16; const v4u o4 = *(const LAS v4u*)(lds + R_KSTG + w * (32 * 272) + (o >> 8) * 272 + (o & 255));
                *(v4u*)(Ko + (size_t)(32 * w) * 128 + (o >> 1)) = o4; } }
    }
    LBAR();
}
#ifndef RET_PF
#define RET_PF 0
#endif
#ifndef RET_KEARLY
#define RET_KEARLY 1
#endif
#ifndef RET_PARK
#define RET_PARK 0
#endif
#ifndef RET_INPLACE
#define RET_INPLACE 0
#endif
#ifndef RET_INPLACE_K
#define RET_INPLACE_K 0
#endif
#ifndef RET_OSTG
#define RET_OSTG 1
#endif
#ifndef RET_VAR
#define RET_VAR 0
#endif
#ifndef RET_ASMST
#define RET_ASMST 0
#endif
__device__ __forceinline__ void st16_asm(void* p, const v4u v) { asm volatile("global_store_dwordx4 %0, %1, off\n\ts_nop 1" :: "v"(p), "v"(v) : "memory"); }
__device__ __forceinline__ void atomic_addf_asm(float* p, float v) { asm volatile("global_atomic_add_f32 %0, %1, off" :: "v"(p), "v"(v) : "memory"); }
template <bool DRY> __device__ __forceinline__ void ret_phase(Frame& F, const bf16* Q, const bf16* KDT, bf16* V, const bf16* G, const bf16x8* ATT, float* SSQ) {
    int w = F.wave; asm volatile("" : "+s"(w));
    LAS unsigned char* const lds = F.lds;
    for (int unit = F.vcu; unit < 256; unit += F.G) {
        const int lane = hw_lane(), tid = w * 64 + lane, g = lane >> 4, r16 = lane & 15, q4 = r16 >> 2, p4 = r16 & 3;
        const int bh = unit >> 3, vs = unit & 7, b = bh >> 2, h = bh & 3;
        const int ct = w < 4 ? w : 11 - w;
        const float lg2 = __builtin_log2f(1.0f - __builtin_amdgcn_exp2f(-5.0f - (float)h));
        const float dec_chunk = __builtin_amdgcn_exp2f(128.0f * lg2), qscale = __builtin_amdgcn_exp2f((float)(16 * ct + r16 + 1) * lg2);
        f32x4 Sacc[2][4];
#pragma unroll
        for (int kt = 0; kt < 2; ++kt)
#pragma unroll
            for (int vt = 0; vt < 4; ++vt) Sacc[kt][vt] = (f32x4){0.f, 0.f, 0.f, 0.f};
        const bf16* Qg = Q + (size_t)b * SEQ * 1024 + h * 256 + (size_t)(16 * ct + r16) * 1024 + 8 * g;
        const bf16* Kt = KDT + (size_t)bh * 64 * 256 * 128 + (size_t)(32 * w + r16) * 128 + 8 * g;
        bf16* Vg = V + (size_t)b * SEQ * 2048 + h * 512 + vs * 64;
        const bf16* Gu = G + (size_t)b * SEQ * 2048 + h * 512 + vs * 64; const unsigned goff = (unsigned)((16 * ct + r16) * 2048 + 4 * g) * 2u;
#define Gg ((const bf16*)((const char*)Gu + goff))
        const unsigned vldoff = (unsigned)((tid >> 3) * 2048 + (tid & 7) * 8) * 2u;
#define Vld ((const bf16*)((const char*)Vg + vldoff))
        const bf16x8* Ag = ATT + (((size_t)bh * 64 * 8 + ct) * 4) * 64 + lane;
        v4u Vr[2]; bf16x8 Qf[8], Kf[2][4], Af[4]; f32x4 otp[4]; v2u gvp[4]; unsigned pf = 0u;
#pragma unroll
        for (int vt = 0; vt < 4; ++vt) { otp[vt] = (f32x4){0.f, 0.f, 0.f, 0.f}; gvp[vt] = (v2u){0u, 0u}; }
        LBAR();
#pragma unroll
        for (int i = 0; i < 2; ++i) { const v4u v0 = *(const v4u*)(Vld + (size_t)i * 64 * 2048); *(LAS v4u*)(lds + R_VT0 + ((tid >> 3) + 64 * i) * R_VS + (tid & 7) * 16) = v0; Vr[i] = *(const v4u*)(Vld + (size_t)(128 + i * 64) * 2048); }
#pragma unroll
        for (int kt = 0; kt < 2; ++kt)
#pragma unroll
            for (int vt = 0; vt < 4; ++vt) *(LAS v2u*)(lds + R_ST0 + (16 * vt + r16) * R_KS + (32 * w + 16 * kt + 4 * g) * 2) = (v2u){0u, 0u};
#pragma unroll
        for (int ks = 0; ks < 8; ++ks) Qf[ks] = *(const bf16x8*)(Qg + 32 * ks);
#pragma unroll
        for (int kt = 0; kt < 2; ++kt)
#pragma unroll
            for (int ss = 0; ss < 4; ++ss) Kf[kt][ss] = *(const bf16x8*)(Kt + kt * 16 * 128 + 32 * ss);
#pragma unroll
        for (int sp = 0; sp < 4; ++sp) if (2 * sp <= ct) Af[sp] = Ag[sp * 64];
        LBAR();
        for (int n = 0; n < 64; ++n) {
            const int cur = n & 1; const int vt_cur = cur ? R_VT1 : R_VT0, vt_alt = cur ? R_VT0 : R_VT1, st_cur = cur ? R_ST1 : R_ST0, st_alt = cur ? R_ST0 : R_ST1;
            if (!RET_ASMST || DRY) asm volatile("" :: "v"(Af[0]), "v"(Kf[1][3]), "v"(Qf[7]), "v"(Vr[1]), "v"(gvp[3]), "v"(pf));
            if (n > 0) { const size_t row = (size_t)(n - 1) * 128 + 16 * ct + r16; float ss = 0.f;
              if (RET_PARK) {
#pragma unroll
                  for (int vt = 0; vt < 4; ++vt) otp[vt] = *(const LAS f32x4*)(lds + R_PK + vt * 8192 + tid * 16); }
#pragma unroll
              for (int vt = 0; vt < 4; ++vt) { v2u o2; o2.x = cvtpk(otp[vt][0] * blo(gvp[vt].x), otp[vt][1] * bhi(gvp[vt].x)); o2.y = cvtpk(otp[vt][2] * blo(gvp[vt].y), otp[vt][3] * bhi(gvp[vt].y));
                  if (RET_OSTG) *(LAS v2u*)(lds + R_PK + w * 2304 + r16 * 144 + (16 * vt + 4 * g) * 2) = o2;
                  else if (!DRY) *(v2u*)(Vg + row * 2048 + 16 * vt + 4 * g) = o2; else asm volatile("" :: "v"(o2.x), "v"(o2.y));
                  ss += (otp[vt][0] * otp[vt][0] + otp[vt][1] * otp[vt][1]) + (otp[vt][2] * otp[vt][2] + otp[vt][3] * otp[vt][3]); }
              if (RET_OSTG) {
#pragma unroll
                  for (int i = 0; i < 2; ++i) { const v4u o4 = *(const LAS v4u*)(lds + R_PK + w * 2304 + (8 * i + (lane >> 3)) * 144 + (lane & 7) * 16);
                      if (!DRY) { if (RET_ASMST) st16_asm(Vg + ((size_t)(n - 1) * 128 + 16 * ct + 8 * i + (lane >> 3)) * 2048 + (lane & 7) * 8, o4); else *(v4u*)(Vg + ((size_t)(n - 1) * 128 + 16 * ct + 8 * i + (lane >> 3)) * 2048 + (lane & 7) * 8) = o4; } else asm volatile("" :: "v"(o4.x), "v"(o4.y), "v"(o4.z), "v"(o4.w)); } }
              ss += __shfl_xor(ss, 16); ss += __shfl_xor(ss, 32);
              if (g == 0 && !DRY) { if (RET_ASMST) atomic_addf_asm(SSQ + ((size_t)b * SEQ + row) * 4 + h, ss); else atomicAdd(SSQ + ((size_t)b * SEQ + row) * 4 + h, ss); } if (DRY) asm volatile("" :: "v"(ss)); }
            if (n + 1 < 64) {
#pragma unroll
                for (int i = 0; i < 2; ++i) *(LAS v4u*)(lds + vt_alt + ((tid >> 3) + 64 * i) * R_VS + (tid & 7) * 16) = Vr[i];
            }
            if (RET_PF && n + 2 < 64 && w < 3) {
                const bf16* pp = w == 0 ? Q + (size_t)b * SEQ * 1024 + ((size_t)(n + 2) * 128 + vs * 16 + (lane >> 2)) * 1024 + h * 256 + (lane & 3) * 64
                               : w == 1 ? KDT + ((size_t)bh * 64 + (n + 2)) * 256 * 128 + (size_t)(vs * 64 + lane) * 64
                                        : (const bf16*)ATT + ((size_t)bh * 64 + (n + 2)) * 16384 + (size_t)(vs * 32 + (lane & 31)) * 64;
                pf = *(const unsigned*)pp; }
            v2u gv[4];
#pragma unroll
            for (int vt = 0; vt < 4; ++vt) gv[vt] = (DRY && RET_VAR >= 2) ? gvp[vt] : *(const v2u*)(Gg + (size_t)n * 128 * 2048 + 16 * vt);
            if (n + 2 < 64 && !(DRY && RET_VAR >= 2)) {
#pragma unroll
                for (int i = 0; i < 2; ++i) Vr[i] = *(const v4u*)(Vld + ((size_t)(n + 2) * 128 + i * 64) * 2048);
            }
#pragma unroll
            for (int kt = 0; kt < 2; ++kt)
#pragma unroll
                for (int vt = 0; vt < 4; ++vt) Sacc[kt][vt] = Sacc[kt][vt] * dec_chunk;
#pragma unroll
            for (int ss = 0; ss < 4; ++ss) {
#pragma unroll
                for (int vt = 0; vt < 4; ++vt) { const LAS unsigned char* p = lds + vt_cur + (32 * ss + 8 * g + q4) * R_VS + (16 * vt + 4 * p4) * 2; const bf16x8 bv = trpair(p, p + 4 * R_VS);
#pragma unroll
                    for (int kt = 0; kt < 2; ++kt) Sacc[kt][vt] = MFMA16(Kf[kt][ss], bv, Sacc[kt][vt]); }
                if (RET_INPLACE_K && n + 1 < 64 && !(DRY && RET_VAR >= 1)) {
                    __builtin_amdgcn_sched_barrier(0);
#pragma unroll
                    for (int kt = 0; kt < 2; ++kt) Kf[kt][ss] = *(const bf16x8*)(Kt + (size_t)(n + 1) * 256 * 128 + kt * 16 * 128 + 32 * ss);
                    __builtin_amdgcn_sched_barrier(0); } }
#pragma unroll
            for (int kt = 0; kt < 2; ++kt)
#pragma unroll
                for (int vt = 0; vt < 4; ++vt) { v2u s2; s2.x = cvtpk(Sacc[kt][vt][0], Sacc[kt][vt][1]); s2.y = cvtpk(Sacc[kt][vt][2], Sacc[kt][vt][3]);
                    *(LAS v2u*)(lds + st_alt + (16 * vt + r16) * R_KS + (32 * w + 16 * kt + 4 * g) * 2) = s2; }
            if (!RET_INPLACE_K && RET_KEARLY && n + 1 < 64 && !(DRY && RET_VAR >= 1)) {
                __builtin_amdgcn_sched_barrier(0);
#pragma unroll
                for (int kt = 0; kt < RET_KEARLY; ++kt)
#pragma unroll
                    for (int ss = 0; ss < 4; ++ss) Kf[kt][ss] = *(const bf16x8*)(Kt + (size_t)(n + 1) * 256 * 128 + kt * 16 * 128 + 32 * ss);
                __builtin_amdgcn_sched_barrier(0);
            }
            f32x4 ot[4];
#pragma unroll
            for (int vt = 0; vt < 4; ++vt) ot[vt] = (f32x4){0.f, 0.f, 0.f, 0.f};
            {
              bf16x8 sa[2][4];
#pragma unroll
              for (int vt = 0; vt < 4; ++vt) sa[0][vt] = *(const LAS bf16x8*)(lds + st_cur + (16 * vt + r16) * R_KS + (8 * g) * 2);
#pragma unroll
              for (int ks = 0; ks < 8; ++ks) {
                  if (ks + 1 < 8) {
#pragma unroll
                      for (int vt = 0; vt < 4; ++vt) sa[(ks + 1) & 1][vt] = *(const LAS bf16x8*)(lds + st_cur + (16 * vt + r16) * R_KS + (32 * (ks + 1) + 8 * g) * 2); }
                  __builtin_amdgcn_sched_barrier(0);
#pragma unroll
                  for (int vt = 0; vt < 4; ++vt) ot[vt] = MFMA16(sa[ks & 1][vt], Qf[ks], ot[vt]);
                  __builtin_amdgcn_sched_barrier(0);
                  if (RET_INPLACE && n + 1 < 64 && !(DRY && RET_VAR >= 1)) { Qf[ks] = *(const bf16x8*)(Qg + (size_t)(n + 1) * 128 * 1024 + 32 * ks); __builtin_amdgcn_sched_barrier(0); }
              } }
#pragma unroll
            for (int vt = 0; vt < 4; ++vt) ot[vt] = ot[vt] * qscale;
            if (n + 1 < 64 && !(DRY && RET_VAR >= 1)) {
                if (!RET_INPLACE) {
#pragma unroll
                for (int ks = 0; ks < 8; ++ks) Qf[ks] = *(const bf16x8*)(Qg + (size_t)(n + 1) * 128 * 1024 + 32 * ks); }
                if (!RET_INPLACE_K) {
#pragma unroll
                for (int kt = RET_KEARLY; kt < 2; ++kt)
#pragma unroll
                    for (int ss = 0; ss < 4; ++ss) Kf[kt][ss] = *(const bf16x8*)(Kt + (size_t)(n + 1) * 256 * 128 + kt * 16 * 128 + 32 * ss);
                }
            }
#pragma unroll
            for (int sp = 0; sp < 4; ++sp) if (2 * sp <= ct) {
#pragma unroll
                for (int vt = 0; vt < 4; ++vt) { const LAS unsigned char* p = lds + vt_cur + (32 * sp + 4 * g + q4) * R_VS + (16 * vt + 4 * p4) * 2;
                    ot[vt] = MFMA16(trpair(p, p + 16 * R_VS), Af[sp], ot[vt]); }
                if (RET_INPLACE && n + 1 < 64 && !(DRY && RET_VAR >= 1)) { __builtin_amdgcn_sched_barrier(0); Af[sp] = Ag[((size_t)(n + 1) * 32 + sp) * 64]; __builtin_amdgcn_sched_barrier(0); } }
            if (!RET_INPLACE && n + 1 < 64 && !(DRY && RET_VAR >= 1)) {
#pragma unroll
                for (int sp = 0; sp < 4; ++sp) if (2 * sp <= ct) Af[sp] = Ag[((size_t)(n + 1) * 32 + sp) * 64];
            }
#pragma unroll
            for (int vt = 0; vt < 4; ++vt) { if (RET_PARK) *(LAS f32x4*)(lds + R_PK + vt * 8192 + tid * 16) = ot[vt]; else otp[vt] = ot[vt]; gvp[vt] = gv[vt]; }
            LBAR();
        }
        { const size_t row = (size_t)63 * 128 + 16 * ct + r16; float ss = 0.f;
          if (RET_PARK) {
#pragma unroll
              for (int vt = 0; vt < 4; ++vt) otp[vt] = *(const LAS f32x4*)(lds + R_PK + vt * 8192 + tid * 16); }
#pragma unroll
          for (int vt = 0; vt < 4; ++vt) { v2u o2; o2.x = cvtpk(otp[vt][0] * blo(gvp[vt].x), otp[vt][1] * bhi(gvp[vt].x)); o2.y = cvtpk(otp[vt][2] * blo(gvp[vt].y), otp[vt][3] * bhi(gvp[vt].y));
              if (RET_OSTG) *(LAS v2u*)(lds + R_PK + w * 2304 + r16 * 144 + (16 * vt + 4 * g) * 2) = o2;
              else if (!DRY) *(v2u*)(Vg + row * 2048 + 16 * vt + 4 * g) = o2; else asm volatile("" :: "v"(o2.x), "v"(o2.y));
              ss += (otp[vt][0] * otp[vt][0] + otp[vt][1] * otp[vt][1]) + (otp[vt][2] * otp[vt][2] + otp[vt][3] * otp[vt][3]); }
          if (RET_OSTG) {
#pragma unroll
              for (int i = 0; i < 2; ++i) { const v4u o4 = *(const LAS v4u*)(lds + R_PK + w * 2304 + (8 * i + (lane >> 3)) * 144 + (lane & 7) * 16);
                  if (!DRY) *(v4u*)(Vg + ((size_t)63 * 128 + 16 * ct + 8 * i + (lane >> 3)) * 2048 + (lane & 7) * 8) = o4; else asm volatile("" :: "v"(o4.x), "v"(o4.y), "v"(o4.z), "v"(o4.w)); } }
          ss += __shfl_xor(ss, 16); ss += __shfl_xor(ss, 32);
          if (g == 0 && !DRY) atomicAdd(SSQ + ((size_t)b * SEQ + row) * 4 + h, ss); if (DRY) asm volatile("" :: "v"(ss)); }
        LBAR();
    }
#undef Gg
#undef Vld
}

constexpr int A_KS = 144;
constexpr int A_KT = 0, A_VT = 256 * A_KS, A_END = 2 * 256 * A_KS, A_STG = A_END;
#ifndef SWA_OSTG
#define SWA_OSTG 1
#endif
__device__ __forceinline__ void swa_phase(Frame& F, const bf16* E, const float* sinks, bf16* OAB) {
    int w = F.wave; asm volatile("" : "+s"(w)); const int lane = hw_lane(), tid = w * 64 + lane, g = lane >> 4, r16 = lane & 15, q4 = r16 >> 2, p4 = r16 & 3;
    LAS unsigned char* const lds = F.lds;
    const int hr = w >> 1, hf = w & 1;
    constexpr float LOG2E = 1.4426950408889634f;
    for (int unit = F.vcu; unit < 1024; unit += F.G) {
        const int b = unit >> 7, nb = (unit >> 1) & 63, gk = unit & 1, hq = 4 * gk + hr;
        const size_t row0 = (size_t)b * SEQ + (size_t)nb * 128;
        LBAR();
#pragma unroll
        for (int i = 0; i < 4; ++i) { const int idx = i * 512 + tid, kr = idx >> 3, c = idx & 7; const bool valid = (nb > 0) || (kr >= 128);
            v4u kv = (v4u){0u, 0u, 0u, 0u}, vv = (v4u){0u, 0u, 0u, 0u};
            if (valid) { const bf16* src = E + (row0 + kr - 128) * EVEN_IN + gk * 64 + c * 8; kv = *(const v4u*)(src + 2560); vv = *(const v4u*)(src + 2688); }
            *(LAS v4u*)(lds + A_KT + kr * A_KS + c * 16) = kv; *(LAS v4u*)(lds + A_VT + kr * A_KS + c * 16) = vv; }
        LBAR();
        const float sk = sinks[hq] * LOG2E;
        const bf16* Qb = E + (row0 + 64 * hf + r16) * EVEN_IN + 2048 + hq * 64 + 8 * g;
        bf16x8 qf[2], qn[2]; v2u o2p[4];
#pragma unroll
        for (int ks = 0; ks < 2; ++ks) { qf[ks] = *(const bf16x8*)(Qb + 32 * ks); qn[ks] = *(const bf16x8*)(Qb + (size_t)16 * EVEN_IN + 32 * ks); }
#pragma unroll
        for (int dt = 0; dt < 4; ++dt) o2p[dt] = (v2u){0u, 0u};
        for (int qt = 0; qt < 4; ++qt) {
            const int qi = 64 * hf + 16 * qt + r16, ft = (4 * hf + qt) & ~1;
            if (qt > 0) {
#pragma unroll
                for (int dt = 0; dt < 4; ++dt) { if (SWA_OSTG) *(LAS v2u*)(lds + A_STG + w * 2304 + r16 * 144 + (16 * dt + 4 * g) * 2) = o2p[dt]; else *(v2u*)(OAB + (row0 + qi - 16) * D + 512 + hq * 64 + 16 * dt + 4 * g) = o2p[dt]; }
                if (SWA_OSTG) {
#pragma unroll
                    for (int i = 0; i < 2; ++i) { const v4u o4 = *(const LAS v4u*)(lds + A_STG + w * 2304 + (8 * i + (lane >> 3)) * 144 + (lane & 7) * 16);
                        *(v4u*)(OAB + (row0 + 64 * hf + 16 * (qt - 1) + 8 * i + (lane >> 3)) * D + 512 + hq * 64 + (lane & 7) * 8) = o4; } } }
            bf16x8 q2[2] = {qn[0], qn[1]};
            if (qt + 2 < 4) {
#pragma unroll
                for (int ks = 0; ks < 2; ++ks) q2[ks] = *(const bf16x8*)(Qb + (size_t)(16 * (qt + 2)) * EVEN_IN + 32 * ks); }
            f32x4 st[10]; float mx = sk;
            { bf16x8 ka[2][10];
#pragma unroll
              for (int ks = 0; ks < 2; ++ks)
#pragma unroll
                  for (int j = 0; j < 10; ++j) ka[ks][j] = *(const LAS bf16x8*)(lds + A_KT + (16 * (ft + j) + r16) * A_KS + (32 * ks + 8 * g) * 2);
              __builtin_amdgcn_sched_barrier(0);
#pragma unroll
              for (int j = 0; j < 10; ++j) st[j] = MFMA16(ka[0][j], qf[0], ((f32x4){0.f, 0.f, 0.f, 0.f}));
#pragma unroll
              for (int j = 0; j < 10; ++j) st[j] = MFMA16(ka[1][j], qf[1], st[j]);
              __builtin_amdgcn_sched_barrier(0); }
            {
              const int tq = 4 * hf + qt;
#pragma unroll
              for (int j = 0; j < 10; ++j) { const int T = ft + j;
                  if (T > tq && T < tq + 8 && (nb > 0 || T >= 8)) {
#pragma unroll
                      for (int r = 0; r < 4; ++r) { const float s2 = st[j][r] * (0.125f * LOG2E); st[j][r] = s2; mx = fmaxf(mx, s2); }
                  } else if (T == tq || T == tq + 8) {
#pragma unroll
                      for (int r = 0; r < 4; ++r) { const int kj = 16 * T + 4 * g + r; const bool valid = (kj > qi) && (kj <= qi + 128) && ((nb > 0) || (kj >= 128));
                          const float s2 = valid ? st[j][r] * (0.125f * LOG2E) : -__builtin_inff(); st[j][r] = s2; mx = fmaxf(mx, s2); }
                  } else {
#pragma unroll
                      for (int r = 0; r < 4; ++r) st[j][r] = -__builtin_inff();
                  } } }
            mx = fmaxf(mx, __shfl_xor(mx, 16)); mx = fmaxf(mx, __shfl_xor(mx, 32));
            float sum = 0.f;
#pragma unroll
            for (int j = 0; j < 10; ++j)
#pragma unroll
                for (int r = 0; r < 4; ++r) { const float p = __builtin_amdgcn_exp2f(st[j][r] - mx); st[j][r] = p; sum += p; }
            sum += __shfl_xor(sum, 16); sum += __shfl_xor(sum, 32);
            const float inv = 1.0f / (sum + __builtin_amdgcn_exp2f(sk - mx));
            f32x4 o[4];
#pragma unroll
            for (int dt = 0; dt < 4; ++dt) o[dt] = (f32x4){0.f, 0.f, 0.f, 0.f};
            { bf16x8 va[2][4];
#pragma unroll
              for (int dt = 0; dt < 4; ++dt) { const LAS unsigned char* p = lds + A_VT + (16 * ft + 4 * g + q4) * A_KS + (16 * dt + 4 * p4) * 2; va[0][dt] = trpair(p, p + 16 * A_KS); }
#pragma unroll
              for (int sp = 0; sp < 5; ++sp) { const bf16x8 bfr = pack_acc2(st[2 * sp], st[2 * sp + 1]);
                  if (sp + 1 < 5) {
#pragma unroll
                      for (int dt = 0; dt < 4; ++dt) { const LAS unsigned char* p = lds + A_VT + (16 * (ft + 2 * (sp + 1)) + 4 * g + q4) * A_KS + (16 * dt + 4 * p4) * 2; va[(sp + 1) & 1][dt] = trpair(p, p + 16 * A_KS); } }
                  __builtin_amdgcn_sched_barrier(0);
#pragma unroll
                  for (int dt = 0; dt < 4; ++dt) o[dt] = MFMA16(va[sp & 1][dt], bfr, o[dt]);
                  __builtin_amdgcn_sched_barrier(0); } }
#pragma unroll
            for (int dt = 0; dt < 4; ++dt) { o2p[dt].x = cvtpk(o[dt][0] * inv, o[dt][1] * inv); o2p[dt].y = cvtpk(o[dt][2] * inv, o[dt][3] * inv); }
#pragma unroll
            for (int ks = 0; ks < 2; ++ks) { qf[ks] = qn[ks]; qn[ks] = q2[ks]; }
        }
#pragma unroll
        for (int dt = 0; dt < 4; ++dt) { if (SWA_OSTG) *(LAS v2u*)(lds + A_STG + w * 2304 + r16 * 144 + (16 * dt + 4 * g) * 2) = o2p[dt]; else *(v2u*)(OAB + (row0 + 64 * hf + 48 + r16) * D + 512 + hq * 64 + 16 * dt + 4 * g) = o2p[dt]; }
        if (SWA_OSTG) {
#pragma unroll
            for (int i = 0; i < 2; ++i) { const v4u o4 = *(const LAS v4u*)(lds + A_STG + w * 2304 + (8 * i + (lane >> 3)) * 144 + (lane & 7) * 16);
                *(v4u*)(OAB + (row0 + 64 * hf + 48 + 8 * i + (lane >> 3)) * D + 512 + hq * 64 + (lane & 7) * 8) = o4; } }
    }
    LBAR();
}

#ifndef PROBE_HBD
#define PROBE_HBD 0
#endif
#ifndef PROBE_HBV
#define PROBE_HBV 1
#endif
#ifndef HG_OSTG
#define HG_OSTG 1
#endif
constexpr int H_S = 272;
constexpr int H_RF = 0, H_RQ = 16384, H_VT = 32768, H_QS = H_VT + 64 * H_S, H_KS = H_QS + 64 * H_S, H_KD = H_KS + 64 * H_S, H_ST = H_KD + 64 * H_S, H_TP = H_ST + 128 * H_S, H_DEC = H_TP + 4096, H_SSX = H_DEC + 512, H_END = H_SSX + 512;
static_assert(H_END <= LDSCTL_OFF, "HGRN2 LDS map");
template <bool PASSB, int HV = 0>
__device__ __forceinline__ void hgrn_pass(Frame& F, const bf16* E, const float* hgrn_lb, const float* og, float* SEGL, float* SEGD, bf16* OAB) {
    int w = F.wave; asm volatile("" : "+s"(w)); const int lane = hw_lane(), tid = w * 64 + lane, g = lane >> 4, r16 = lane & 15, q4 = r16 >> 2, p4 = r16 & 3;
    const int ct = w & 3, vh = w >> 2, kp = w & 3;
    LAS unsigned char* const lds = F.lds;
    for (int unit = F.vcu; unit < 256; unit += F.G) {
        const int bh = unit >> 3, seg = unit & 7, b = bh >> 2, h = bh & 3;
        const float lbA = fsig(hgrn_lb[h * 128 + 2 * lane] - hgrn_lb[512 + h * 128 + 2 * lane]), lbB = fsig(hgrn_lb[h * 128 + 2 * lane + 1] - hgrn_lb[512 + h * 128 + 2 * lane + 1]);
        f32x4 ggv[4];
#pragma unroll
        for (int vt = 0; vt < 4; ++vt) ggv[vt] = PASSB ? *(const f32x4*)(og + 64 * vh + 16 * vt + 4 * g) : (f32x4){0.f, 0.f, 0.f, 0.f};
        f32x4 Sacc[2][4];
#pragma unroll
        for (int kt = 0; kt < 2; ++kt)
#pragma unroll
            for (int vt = 0; vt < 4; ++vt) Sacc[kt][vt] = (f32x4){0.f, 0.f, 0.f, 0.f};
        if (PASSB) {
            for (int j = 0; j < seg; ++j) { const float* Lj = SEGL + (size_t)(bh * 8 + j) * 512 * 32 + tid * 4;     const float* Dj = SEGD + (size_t)(bh * 8 + j) * 128 + 32 * kp + 4 * g;
#pragma unroll
                for (int kt = 0; kt < 2; ++kt) { const f32x4 dl = *(const f32x4*)(Dj + 16 * kt); f32x4 dd;
#pragma unroll
                    for (int r = 0; r < 4; ++r) dd[r] = __builtin_amdgcn_exp2f(dl[r]);
#pragma unroll
                    for (int vt = 0; vt < 4; ++vt) Sacc[kt][vt] = Sacc[kt][vt] * dd + *(const f32x4*)(Lj + (kt * 4 + vt) * 2048); } }
        }
        float ldA = 0.f, ldB = 0.f;
        const size_t rowbase = (size_t)b * SEQ + (size_t)seg * 1024;
        const bf16* Eld = E + (rowbase + (tid >> 4)) * EVEN_IN + h * 128 + (tid & 15) * 8;
        v4u Xq[2], Xf[2], Xv[2]; v2u o2p[4];
#pragma unroll
        for (int vt = 0; vt < 4; ++vt) o2p[vt] = (v2u){0u, 0u};
#pragma unroll
        for (int i = 0; i < 2; ++i) { const bf16* s = Eld + (size_t)(32 * i) * EVEN_IN; if (PASSB) Xq[i] = *(const v4u*)s; Xf[i] = *(const v4u*)(s + 512); Xv[i] = *(const v4u*)(s + 1024); }
        for (int n = 0; n < 16; ++n) {
            const size_t t0 = rowbase + (size_t)n * 64;
            LBAR();
#pragma unroll
            for (int i = 0; i < 2; ++i) { const int row = (tid >> 4) + 32 * i, c = tid & 15;
                if (PASSB) *(LAS v4u*)(lds + H_RQ + row * 256 + c * 16) = Xq[i];
                *(LAS v4u*)(lds + H_RF + row * 256 + c * 16) = Xf[i]; *(LAS v4u*)(lds + H_VT + row * H_S + c * 16) = Xv[i]; }
            if (PASSB) {
#pragma unroll
                for (int kt = 0; kt < 2; ++kt)
#pragma unroll
                    for (int vt = 0; vt < 4; ++vt) { v2u s2; s2.x = cvtpk(Sacc[kt][vt][0], Sacc[kt][vt][1]); s2.y = cvtpk(Sacc[kt][vt][2], Sacc[kt][vt][3]);
                        *(LAS v2u*)(lds + H_ST + (64 * vh + 16 * vt + r16) * H_S + (32 * kp + 16 * kt + 4 * g) * 2) = s2; }
            }
            LBAR();
            if (PASSB) {
                if (n > 0) {
#pragma unroll
                    for (int vt = 0; vt < 4; ++vt) { if (HG_OSTG) *(LAS v2u*)(lds + H_QS + w * 2304 + r16 * 144 + (16 * vt + 4 * g) * 2) = o2p[vt]; else *(v2u*)(OAB + (t0 - 64 + 16 * ct + r16) * D + h * 128 + 64 * vh + 16 * vt + 4 * g) = o2p[vt]; }
                    if (HG_OSTG) {
#pragma unroll
                        for (int i = 0; i < 2; ++i) { const v4u o4 = *(const LAS v4u*)(lds + H_QS + w * 2304 + (8 * i + (lane >> 3)) * 144 + (lane & 7) * 16);
                            if (HV == 0) *(v4u*)(OAB + (t0 - 64 + 16 * ct + 8 * i + (lane >> 3)) * D + h * 128 + 64 * vh + (lane & 7) * 8) = o4; else asm volatile("" :: "v"(o4.x), "v"(o4.y), "v"(o4.z), "v"(o4.w)); } } }
            }
            if (n + 1 < 16 && HV < 2) {
#pragma unroll
                for (int i = 0; i < 2; ++i) { const bf16* s = Eld + (size_t)((n + 1) * 64 + 32 * i) * EVEN_IN; if (PASSB) Xq[i] = *(const v4u*)s; Xf[i] = *(const v4u*)(s + 512); Xv[i] = *(const v4u*)(s + 1024); }
            }
            v2u gav[4];
            if (PASSB) {
#pragma unroll
                for (int vt = 0; vt < 4; ++vt) gav[vt] = HV >= 2 ? o2p[vt] : *(const v2u*)(E + (t0 + 16 * ct + r16) * EVEN_IN + 1536 + h * 128 + 64 * vh + 16 * vt + 4 * g);
            }
            float fA[8], fB[8], cA[8], cB[8];
            { float runA = 0.f, runB = 0.f;
#pragma unroll
              for (int r = 0; r < 8; ++r) { const unsigned wv = *(const LAS unsigned*)(lds + H_RF + (8 * w + r) * 256 + lane * 4);
                  const float a = lbA + (1.0f - lbA) * fsg(blo(wv)), bq = lbB + (1.0f - lbB) * fsg(bhi(wv)); fA[r] = a; fB[r] = bq;
                  runA += __builtin_amdgcn_logf(a); runB += __builtin_amdgcn_logf(bq); cA[r] = runA; cB[r] = runB; }
              *(LAS f32x2_t*)(lds + H_TP + (w * 128 + 2 * lane) * 4) = (f32x2_t){runA, runB}; }
            LBAR();
            { float offA = 0.f, offB = 0.f, blA = 0.f, blB = 0.f;
#pragma unroll
              for (int pp = 0; pp < 8; ++pp) { const f32x2_t t = *(const LAS f32x2_t*)(lds + H_TP + (pp * 128 + 2 * lane) * 4); blA += t.x; blB += t.y; if (pp < w) { offA += t.x; offB += t.y; } }
#pragma unroll
              for (int r = 0; r < 8; ++r) { const int t = 8 * w + r; const float bbA = offA + cA[r], bbB = offB + cB[r], kkA = 1.0f - fA[r], kkB = 1.0f - fB[r];
                  *(LAS unsigned*)(lds + H_KD + t * H_S + lane * 4) = cvtpk(kkA * __builtin_amdgcn_exp2f(blA - bbA), kkB * __builtin_amdgcn_exp2f(blB - bbB));
                  if (PASSB) { const unsigned qw = *(const LAS unsigned*)(lds + H_RQ + t * 256 + lane * 4); const float qa = blo(qw), qb = bhi(qw);
                      *(LAS unsigned*)(lds + H_QS + t * H_S + lane * 4) = cvtpk(qa * fsg(qa) * __builtin_amdgcn_exp2f(bbA), qb * fsg(qb) * __builtin_amdgcn_exp2f(bbB));
                      *(LAS unsigned*)(lds + H_KS + t * H_S + lane * 4) = cvtpk(kkA * __builtin_amdgcn_exp2f(-bbA), kkB * __builtin_amdgcn_exp2f(-bbB)); } }
              if (w == 0) { *(LAS f32x2_t*)(lds + H_DEC + 2 * lane * 4) = (f32x2_t){__builtin_amdgcn_exp2f(blA), __builtin_amdgcn_exp2f(blB)}; ldA += blA; ldB += blB; } }
            LBAR();
            f32x4 ot[4];
            if (PASSB) {
                bf16x8 Qf[4];
#pragma unroll
                for (int ks = 0; ks < 4; ++ks) Qf[ks] = *(const LAS bf16x8*)(lds + H_QS + (16 * ct + r16) * H_S + (32 * ks + 8 * g) * 2);
                f32x4 at[4]; bf16x8 ka[2][4];
#pragma unroll
                for (int ks = 0; ks < 4; ++ks) ka[0][ks] = *(const LAS bf16x8*)(lds + H_KS + r16 * H_S + (32 * ks + 8 * g) * 2);
#pragma unroll
                for (int st = 0; st < 4; ++st) { at[st] = (f32x4){0.f, 0.f, 0.f, 0.f};
                    if (st <= ct) {
                        if (st + 1 < 4 && st + 1 <= ct) {
#pragma unroll
                            for (int ks = 0; ks < 4; ++ks) ka[(st + 1) & 1][ks] = *(const LAS bf16x8*)(lds + H_KS + (16 * (st + 1) + r16) * H_S + (32 * ks + 8 * g) * 2); }
                        __builtin_amdgcn_sched_barrier(0);
#pragma unroll
                        for (int ks = 0; ks < 4; ++ks) at[st] = MFMA16(ka[st & 1][ks], Qf[ks], at[st]);
                        __builtin_amdgcn_sched_barrier(0);
#pragma unroll
                        for (int r = 0; r < 4; ++r) if (16 * ct + r16 < 16 * st + 4 * g + r) at[st][r] = 0.f;
                    } }
                bf16x8 sa[2][4];
#pragma unroll
                for (int ks = 0; ks < 4; ++ks) sa[0][ks] = *(const LAS bf16x8*)(lds + H_ST + (64 * vh + r16) * H_S + (32 * ks + 8 * g) * 2);
#pragma unroll
                for (int vt = 0; vt < 4; ++vt) { ot[vt] = (f32x4){0.f, 0.f, 0.f, 0.f};
                    if (vt + 1 < 4) {
#pragma unroll
                        for (int ks = 0; ks < 4; ++ks) sa[(vt + 1) & 1][ks] = *(const LAS bf16x8*)(lds + H_ST + (64 * vh + 16 * (vt + 1) + r16) * H_S + (32 * ks + 8 * g) * 2); }
                    __builtin_amdgcn_sched_barrier(0);
#pragma unroll
                    for (int ks = 0; ks < 4; ++ks) ot[vt] = MFMA16(sa[vt & 1][ks], Qf[ks], ot[vt]);
                    __builtin_amdgcn_sched_barrier(0); }
#pragma unroll
                for (int sp = 0; sp < 2; ++sp) if (2 * sp <= ct) { const bf16x8 bfr = pack_acc2(at[2 * sp], at[2 * sp + 1]);
#pragma unroll
                    for (int vt = 0; vt < 4; ++vt) { const LAS unsigned char* p = lds + H_VT + (32 * sp + 4 * g + q4) * H_S + (64 * vh + 16 * vt + 4 * p4) * 2; ot[vt] = MFMA16(trpair(p, p + 16 * H_S), bfr, ot[vt]); } }
            }
#pragma unroll
            for (int kt = 0; kt < 2; ++kt) { const f32x4 dd = *(const LAS f32x4*)(lds + H_DEC + (32 * kp + 16 * kt + 4 * g) * 4);
#pragma unroll
                for (int vt = 0; vt < 4; ++vt) Sacc[kt][vt] = Sacc[kt][vt] * dd; }
#pragma unroll
            for (int ss = 0; ss < 2; ++ss) { bf16x8 af[2];
#pragma unroll
                for (int kt = 0; kt < 2; ++kt) { const LAS unsigned char* p = lds + H_KD + (32 * ss + 8 * g + q4) * H_S + (32 * kp + 16 * kt + 4 * p4) * 2; af[kt] = trpair(p, p + 4 * H_S); }
#pragma unroll
                for (int vt = 0; vt < 4; ++vt) { const LAS unsigned char* p = lds + H_VT + (32 * ss + 8 * g + q4) * H_S + (64 * vh + 16 * vt + 4 * p4) * 2; const bf16x8 bv = trpair(p, p + 4 * H_S);
#pragma unroll
                    for (int kt = 0; kt < 2; ++kt) Sacc[kt][vt] = MFMA16(af[kt], bv, Sacc[kt][vt]); } }
            if (PASSB) {
                float ss = 0.f;
#pragma unroll
                for (int vt = 0; vt < 4; ++vt) ss += (ot[vt][0] * ot[vt][0] + ot[vt][1] * ot[vt][1]) + (ot[vt][2] * ot[vt][2] + ot[vt][3] * ot[vt][3]);
                ss += __shfl_xor(ss, 16); ss += __shfl_xor(ss, 32);
                if (g == 0) *(LAS float*)(lds + H_SSX + (vh * 64 + 16 * ct + r16) * 4) = ss;
                LBAR();
                const float tot = *(const LAS float*)(lds + H_SSX + (16 * ct + r16) * 4) + *(const LAS float*)(lds + H_SSX + (64 + 16 * ct + r16) * 4);
                const float rstd = rsqrtf(tot * (1.0f / 128.0f) + EPS);
#pragma unroll
                for (int vt = 0; vt < 4; ++vt) { const f32x4 gg = ggv[vt];
                    const float a0 = blo(gav[vt].x), a1 = bhi(gav[vt].x), a2 = blo(gav[vt].y), a3 = bhi(gav[vt].y);
                    v2u o2; o2.x = cvtpk(ot[vt][0] * rstd * gg[0] * a0 * fsg(a0), ot[vt][1] * rstd * gg[1] * a1 * fsg(a1)); o2.y = cvtpk(ot[vt][2] * rstd * gg[2] * a2 * fsg(a2), ot[vt][3] * rstd * gg[3] * a3 * fsg(a3));
                    o2p[vt] = o2; }
            }
        }
        if (PASSB) {
#pragma unroll
            for (int vt = 0; vt < 4; ++vt) { if (!HG_OSTG) *(v2u*)(OAB + (rowbase + 15 * 64 + 16 * ct + r16) * D + h * 128 + 64 * vh + 16 * vt + 4 * g) = o2p[vt]; }
            if (HG_OSTG) { LBAR();
#pragma unroll
                for (int vt = 0; vt < 4; ++vt) *(LAS v2u*)(lds + H_QS + w * 2304 + r16 * 144 + (16 * vt + 4 * g) * 2) = o2p[vt];
#pragma unroll
                for (int i = 0; i < 2; ++i) { const v4u o4 = *(const LAS v4u*)(lds + H_QS + w * 2304 + (8 * i + (lane >> 3)) * 144 + (lane & 7) * 16);
                    if (HV == 0) *(v4u*)(OAB + (rowbase + 15 * 64 + 16 * ct + 8 * i + (lane >> 3)) * D + h * 128 + 64 * vh + (lane & 7) * 8) = o4; else asm volatile("" :: "v"(o4.x), "v"(o4.y), "v"(o4.z), "v"(o4.w)); } }
        }
        if (!PASSB) {
            float* Lo = SEGL + (size_t)unit * 512 * 32 + tid * 4;
#pragma unroll
            for (int kt = 0; kt < 2; ++kt)
#pragma unroll
                for (int vt = 0; vt < 4; ++vt) *(f32x4*)(Lo + (kt * 4 + vt) * 2048) = Sacc[kt][vt];
            if (w == 0) *(f32x2_t*)(SEGD + (size_t)unit * 128 + 2 * lane) = (f32x2_t){ldA, ldB};
        }
        LBAR();
    }
}

struct Args { const float* in[18]; float* out; unsigned char* ws; };
#ifndef GEMM_STAGGER
#define GEMM_STAGGER 0
#endif
#ifndef PROBE_GSEL
#define PROBE_GSEL 0
#endif
#ifndef PROBE_GEMM2
#define PROBE_GEMM2 0
#endif
#ifndef PROBE_P0
#define PROBE_P0 0
#endif
#ifndef PROBE_HA
#define PROBE_HA 0
#endif
#ifndef PROBE_SWA
#define PROBE_SWA 0
#endif
#ifndef PROBE_HB
#define PROBE_HB 0
#endif
#ifndef PROBE_MIX2
#define PROBE_MIX2 0
#endif
#ifndef PROBE_ATT2
#define PROBE_ATT2 0
#endif
#ifndef PROBE_RET2
#define PROBE_RET2 0
#endif
#ifndef PROBE_THIN2
#define PROBE_THIN2 0
#endif
#define THIN_DUMMY(NORM2, CONVP, hin, Y, gA, gB, psrc) do { if (PROBE_THIN2) { thin_pass<NORM2, true, CONVP>(F, hin, Y, gA, 0.5f, (float*)BIGP(384 * MiB), gB, (bf16*)BIGP(640 * MiB), psrc, (bf16*)BIGP(704 * MiB)); } } while (0)
__device__ __forceinline__ unsigned long long karg(int idx) {
    const __attribute__((address_space(4))) unsigned char* kp = (const __attribute__((address_space(4))) unsigned char*)__builtin_amdgcn_kernarg_segment_ptr();
    asm volatile("" : "+s"(kp));
    return *(const __attribute__((address_space(4))) unsigned long long*)(kp + 8 * idx);
}
#define IN_F(i) ((const float*)(GAS const float*)karg(i))
#define WSP() ((unsigned char*)(GAS unsigned char*)karg(19))
#define OUTP() ((float*)(GAS float*)karg(18))
#define SW_WORD(i) (((volatile LAS unsigned*)(F.lds + MISC_OFF)) + 32 + (i))
__global__ void __launch_bounds__(NWAVES * 64, 2) mk_fwd(Args args) {
    extern __shared__ __attribute__((aligned(16))) unsigned char lds[];
    Frame F;
    F.lds = (LAS unsigned char*)lds;
    F.wave = __builtin_amdgcn_readfirstlane(threadIdx.x >> 6);
    F.G = gridDim.x; { const int bx = blockIdx.x; F.vcu = (F.G % 8 == 0) ? (bx % 8) * (F.G / 8) + bx / 8 : bx; }
    for (int u = threadIdx.x; u < (LDS_BYTES - LDSCTL_OFF) / 4; u += NWAVES * 64) ((LAS unsigned*)(F.lds + LDSCTL_OFF))[u] = 0u;
    __syncthreads();
    (void)xcd_barrier_post((unsigned*)(WSP() + WS_CTL) + CW_BAR, (volatile LAS unsigned*)(F.lds + MISC_OFF) + 8);
#if PROBE_SKEW
    { int bxk_ = blockIdx.x; asm volatile("" : "+s"(bxk_)); if (bxk_ == 0 && F.wave == 0) ((unsigned*)(WSP() + WS_CTL + 768 * 1024))[60] = (unsigned)__builtin_amdgcn_s_memrealtime(); }
#endif
#if PROBE_SKEW
#define GRID_BAR() do { XcdBarrier bb_; bb_.bar = (unsigned*)(WSP() + WS_CTL) + CW_BAR; bb_.x = xb_xcc_id(); bb_.wv = F.wave; bb_.st = (volatile LAS unsigned*)(F.lds + MISC_OFF) + 8; \
        int bxs_ = blockIdx.x; asm volatile("" : "+s"(bxs_)); volatile LAS unsigned* cw_ = SW_WORD(4); const unsigned bi_ = *cw_; bb_.ts = (unsigned*)(WSP() + WS_CTL + 512 * 1024) + bi_ * 256 + bxs_; xcd_barrier(bb_); if (F.wave == 0) { *cw_ = bi_ + 1; if (bxs_ == 0) ((unsigned*)(WSP() + WS_CTL + 768 * 1024))[bi_] = (unsigned)__builtin_amdgcn_s_memrealtime(); } } while (0)
#else
#define GRID_BAR() do { XcdBarrier bb_; bb_.bar = (unsigned*)(WSP() + WS_CTL) + CW_BAR; bb_.x = xb_xcc_id(); bb_.wv = F.wave; bb_.st = (volatile LAS unsigned*)(F.lds + MISC_OFF) + 8; xcd_barrier(bb_); } while (0)
#endif
#define RING ((PG8_LAS unsigned char*)(F.lds + RING_OFF))
#define HBP ((bf16*)(WSP() + WS_YN))
#define YP ((bf16*)OUTP())
#define RSP ((float*)(WSP() + WS_RS))
#define BIGP(off) (WSP() + WS_BIG + (off))
#define GSEL_ 0
#define GEMM_PHASE(EPI, A_, B_, N_, K_, ...) do { int bx_ = blockIdx.x, G_ = F.G; asm volatile("" : "+s"(bx_), "+s"(G_));     \
        pg8::Gemm gm_{(const bf16*)(A_), (const bf16*)(B_), M, (N_), (K_)}; pg8::StaticOrder S_; S_.init(M, (N_), G_, bx_); S_.wave_id = F.wave; pg8::EPI Ep_{__VA_ARGS__}; \
        if (GEMM_STAGGER > 0 && ((bx_ >> 5) & 1)) { _Pragma("unroll") for (int d_ = 0; d_ < GEMM_STAGGER; ++d_) __builtin_amdgcn_s_sleep(127); }     \
        pg8::gemm_phase<pg8::EPI, pg8::StaticOrder, true, true>(RING, gm_, S_, Ep_); \
        if (PROBE_GEMM2 || (PROBE_GSEL && PROBE_GSEL == GSEL_)) { __syncthreads(); pg8::gemm_phase<pg8::EPI, pg8::StaticOrder, true, true>(RING, gm_, S_, Ep_); } } while (0)

    for (int rep_ = 0; rep_ < (PROBE_P0 ? 2 : 1); ++rep_) {
        LAS float* scr = (LAS float*)(F.lds + RING_OFF + F.wave * 16384);
        int cb_ = 0;
#if P0_PAIR
        for (int l = 0; l < DEPTH; ++l) { unsigned char* wl = WSP() + WS_WB + l * W_LAYER; const float* ng = IN_F(3) + (size_t)l * 7 * D;
            conv_pair<1, 0>(F, IN_F(4) + (size_t)l * D * 2 * FF, D, 2 * FF, (bf16*)(wl + WO_1IN), ng, IN_F(5) + (size_t)l * FF * D, FF, D, (bf16*)(wl + WO_1OUT), nullptr, scr, cb_);
            conv_pair<1, 0>(F, IN_F(6) + (size_t)l * D * 2 * FF, D, 2 * FF, (bf16*)(wl + WO_2IN), ng + 4 * D, IN_F(7) + (size_t)l * FF * D, FF, D, (bf16*)(wl + WO_2OUT), nullptr, scr, cb_);
            conv_pair<0, 0>(F, IN_F(8) + (size_t)l * PLE * D, PLE, D, (bf16*)(wl + WO_PROJ), nullptr, IN_F(9) + (size_t)l * D * D, D, D, (bf16*)(wl + WO_GATE), nullptr, scr, cb_); }
        conv_pair<2, 0>(F, IN_F(10), D, EVEN_IN, (bf16*)(WSP() + WS_WEVIN), IN_F(3) + 2 * D, IN_F(11), D, D, (bf16*)(WSP() + WS_WEVOUT), nullptr, scr, cb_);
        conv_pair<0, 0>(F, IN_F(15), D, ODD_IN, (bf16*)(WSP() + WS_WODIN), IN_F(3) + 9 * D, IN_F(16), 2048, D, (bf16*)(WSP() + WS_WODOUT), nullptr, scr, cb_);
#else
        for (int l = 0; l < DEPTH; ++l) { unsigned char* wl = WSP() + WS_WB + l * W_LAYER; const float* ng = IN_F(3) + (size_t)l * 7 * D;
            conv_matrix<1>(F, IN_F(4) + (size_t)l * D * 2 * FF, D, 2 * FF, (bf16*)(wl + WO_1IN), scr, cb_, ng);
            conv_matrix<3>(F, IN_F(5) + (size_t)l * FF * D, FF, D, (bf16*)(wl + WO_1OUT), scr, cb_);
            conv_matrix<1>(F, IN_F(6) + (size_t)l * D * 2 * FF, D, 2 * FF, (bf16*)(wl + WO_2IN), scr, cb_, ng + 4 * D);
            conv_matrix<3>(F, IN_F(7) + (size_t)l * FF * D, FF, D, (bf16*)(wl + WO_2OUT), scr, cb_);
            conv_matrix<3>(F, IN_F(8) + (size_t)l * PLE * D, PLE, D, (bf16*)(wl + WO_PROJ), scr, cb_);
            conv_matrix<3>(F, IN_F(9) + (size_t)l * D * D, D, D, (bf16*)(wl + WO_GATE), scr, cb_); }
        conv_matrix<2>(F, IN_F(10), D, EVEN_IN, (bf16*)(WSP() + WS_WEVIN), scr, cb_, IN_F(3) + 2 * D);
        conv_matrix<3>(F, IN_F(11), D, D, (bf16*)(WSP() + WS_WEVOUT), scr, cb_);
        conv_matrix<0>(F, IN_F(15), D, ODD_IN, (bf16*)(WSP() + WS_WODIN), scr, cb_, IN_F(3) + 9 * D);
        conv_matrix<3>(F, IN_F(16), 2048, D, (bf16*)(WSP() + WS_WODOUT), scr, cb_);
#endif
#if PROBE_SKEW == 7
        if (F.wave == 0) { int bxq_ = blockIdx.x; asm volatile("" : "+s"(bxq_)); if (bxq_ == PROBE_P0WG) ((unsigned*)(WSP() + WS_CTL + 768 * 1024))[61] = (unsigned)__builtin_amdgcn_s_memrealtime(); }
#endif
        init_rows(F, IN_F(0), HBP, RSP);
#if PROBE_SKEW == 7
        if (F.wave == 0) { int bxq_ = blockIdx.x; asm volatile("" : "+s"(bxq_)); if (bxq_ == PROBE_P0WG) ((unsigned*)(WSP() + WS_CTL + 768 * 1024))[62] = (unsigned)__builtin_amdgcn_s_memrealtime(); }
#endif
        GRID_BAR();
    }
    for (int l = 0; l < DEPTH; ++l) {
#define NG(k) (IN_F(3) + ((size_t)l * 7 + (k)) * D)
#define WL(off) (WSP() + WS_WB + (size_t)l * W_LAYER + (off))
#undef GSEL_
#define GSEL_ 1
        GEMM_PHASE(EpiSwiGLU, HBP, WL(WO_1IN), 2 * FF, D, (bf16*)BIGP(BIG_ACT), FF); GRID_BAR();
#undef GSEL_
#define GSEL_ 2
        GEMM_PHASE(EpiStore, BIGP(BIG_ACT), WL(WO_1OUT), D, FF, YP, D); GRID_BAR();
        if (PROBE_THIN2) { thin_pass<false, false>(F, HBP, YP, NG(1), 0.5f, RSP, nullptr, nullptr, nullptr, (bf16*)BIGP(640 * MiB)); }
        thin_pass<false, false>(F, HBP, YP, NG(1), 0.5f, RSP, nullptr, nullptr, nullptr); GRID_BAR();
        if (l == 0) {
#undef GSEL_
#define GSEL_ 3
            GEMM_PHASE(EpiEvenIn, HBP, WSP() + WS_WEVIN, EVEN_IN, D, (bf16*)BIGP(BIG_E), (const int*)IN_F(2)); GRID_BAR();
            for (int rep_ = 0; rep_ < (PROBE_HA ? PROBE_HA : 1); ++rep_)
            hgrn_pass<false>(F, (const bf16*)BIGP(BIG_E), IN_F(12), IN_F(13), (float*)BIGP(BIG_SEGL), (float*)BIGP(BIG_SEGD), (bf16*)BIGP(BIG_OAB));
            for (int rep_ = 0; rep_ < (PROBE_SWA ? PROBE_SWA : 1); ++rep_)
            swa_phase(F, (const bf16*)BIGP(BIG_E), IN_F(14), (bf16*)BIGP(BIG_OAB));
            GRID_BAR();
            for (int rep_ = 0; rep_ < (PROBE_HB ? PROBE_HB : 1); ++rep_)
            for (int rep_ = 0; rep_ < PROBE_HBD; ++rep_) { hgrn_pass<true, (PROBE_HBV > 0 ? PROBE_HBV : 1)>(F, (const bf16*)BIGP(BIG_E), IN_F(12), IN_F(13), (float*)BIGP(BIG_SEGL), (float*)BIGP(BIG_SEGD), (bf16*)BIGP(BIG_OAB)); }
            hgrn_pass<true>(F, (const bf16*)BIGP(BIG_E), IN_F(12), IN_F(13), (float*)BIGP(BIG_SEGL), (float*)BIGP(BIG_SEGD), (bf16*)BIGP(BIG_OAB));
            GRID_BAR();
#undef GSEL_
#define GSEL_ 4
            GEMM_PHASE(EpiStore, BIGP(BIG_OAB), WSP() + WS_WEVOUT, D, D, YP, D); GRID_BAR();
        } else {
#undef GSEL_
#define GSEL_ 3
            GEMM_PHASE(EpiOddIn, HBP, WSP() + WS_WODIN, ODD_IN, D, (bf16*)BIGP(BIG_Q), (bf16*)BIGP(BIG_K), (bf16*)BIGP(BIG_V), (bf16*)BIGP(BIG_G), (const int*)IN_F(2), IN_F(17)); GRID_BAR();
            ret_att_phase(F, (const bf16*)BIGP(BIG_Q), (const bf16*)BIGP(BIG_K), (bf16x8*)OUTP(), (bf16*)OUTP() + 32 * MiB); GRID_BAR();
            if (PROBE_ATT2) { ret_att_phase(F, (const bf16*)BIGP(BIG_Q), (const bf16*)BIGP(BIG_K), (bf16x8*)OUTP(), (bf16*)OUTP() + 32 * MiB); GRID_BAR(); }
            for (int rep_ = 0; rep_ < PROBE_RET2; ++rep_) { ret_phase<true>(F, (const bf16*)BIGP(BIG_Q), (const bf16*)OUTP() + 32 * MiB, (bf16*)BIGP(BIG_V), (const bf16*)BIGP(BIG_G), (const bf16x8*)OUTP(), (float*)(WSP() + WS_SSQ)); GRID_BAR(); }
            ret_phase<false>(F, (const bf16*)BIGP(BIG_Q), (const bf16*)OUTP() + 32 * MiB, (bf16*)BIGP(BIG_V), (const bf16*)BIGP(BIG_G), (const bf16x8*)OUTP(), (float*)(WSP() + WS_SSQ)); GRID_BAR();
#undef GSEL_
#define GSEL_ 4
            GEMM_PHASE(EpiStoreHS, BIGP(BIG_V), WSP() + WS_WODOUT, D, 2048, YP, D, (const float*)(WSP() + WS_SSQ)); GRID_BAR();
        }
        if (PROBE_THIN2) { thin_pass<false, true>(F, HBP, YP, NG(3), 1.0f, RSP, nullptr, IN_F(1) + (size_t)l * M * PLE, (bf16*)BIGP(BIG_PB), (bf16*)BIGP(640 * MiB)); }
        thin_pass<false, true>(F, HBP, YP, NG(3), 1.0f, RSP, nullptr, IN_F(1) + (size_t)l * M * PLE, (bf16*)BIGP(BIG_PB)); GRID_BAR();
#undef GSEL_
#define GSEL_ 1
        GEMM_PHASE(EpiSwiGLU, HBP, WL(WO_2IN), 2 * FF, D, (bf16*)BIGP(BIG_ACT), FF); GRID_BAR();
#undef GSEL_
#define GSEL_ 2
        GEMM_PHASE(EpiStore, BIGP(BIG_ACT), WL(WO_2OUT), D, FF, YP, D);
#undef GSEL_
#define GSEL_ 4
        GEMM_PHASE(EpiStore, BIGP(BIG_PB), WL(WO_PROJ), D, PLE, (bf16*)BIGP(BIG_T), D); GRID_BAR();
        if (PROBE_THIN2) { thin_pass<false, false>(F, HBP, YP, NG(5), 0.5f, RSP, nullptr, nullptr, nullptr, (bf16*)BIGP(640 * MiB)); }
        thin_pass<false, false>(F, HBP, YP, NG(5), 0.5f, RSP, nullptr, nullptr, nullptr); GRID_BAR();
#undef GSEL_
#define GSEL_ 4
        GEMM_PHASE(EpiPleG, HBP, WL(WO_GATE), D, D, (bf16*)BIGP(BIG_Z), (const bf16*)BIGP(BIG_T), RSP); GRID_BAR();
        if (l == 0) { thin_pass<false, false>(F, HBP, (const bf16*)BIGP(BIG_Z), NG(6), 1.0f, RSP, nullptr, nullptr, nullptr); GRID_BAR(); }
        else thin_pass<true, false>(F, HBP, (const bf16*)BIGP(BIG_Z), NG(6), 1.0f, RSP, OUTP(), nullptr, nullptr);
    }
#if PROBE_SKEW
    { GRID_BAR(); int bx_ = blockIdx.x; asm volatile("" : "+s"(bx_)); if (bx_ == 0 && F.wave == 0) {
        const unsigned nb = *SW_WORD(4); const unsigned* TS = (const unsigned*)(WSP() + WS_CTL + 512 * 1024); const int lane = hw_lane(); unsigned total = 0;
        for (unsigned i = 0; i < nb && i < 64; ++i) { if (!((PROBE_SKEW_MASK >> i) & 1ull)) continue;
            const unsigned base = __hip_atomic_load(TS + i * 256, __ATOMIC_RELAXED, __HIP_MEMORY_SCOPE_AGENT);
            int mx = -2147483647, mn = 2147483647, sm = 0;
            for (int k = 0; k < 4; ++k) { const int d = (int)(__hip_atomic_load(TS + i * 256 + lane * 4 + k, __ATOMIC_RELAXED, __HIP_MEMORY_SCOPE_AGENT) - base); mx = d > mx ? d : mx; mn = d < mn ? d : mn; sm += d; }
            int xs[4];
            for (int k = 0; k < 4; ++k) { xs[k] = (int)(__hip_atomic_load(TS + i * 256 + lane * 4 + k, __ATOMIC_RELAXED, __HIP_MEMORY_SCOPE_AGENT) - base); for (int o = 32; o >= 2; o >>= 1) xs[k] += __shfl_xor(xs[k], o); }
            int xm = xs[0]; for (int k = 1; k < 4; ++k) xm = xs[k] > xm ? xs[k] : xm; { const int a = __shfl_xor(xm, 1); xm = a > xm ? a : xm; }
            for (int o = 32; o; o >>= 1) { const int a = __shfl_xor(mx, o), c = __shfl_xor(mn, o); mx = a > mx ? a : mx; mn = c < mn ? c : mn; sm += __shfl_xor(sm, o); }
            if (PROBE_SKEW == 7) { const unsigned* EX = (const unsigned*)(WSP() + WS_CTL + 768 * 1024); if (i == 0) { const unsigned e60 = __hip_atomic_load(EX + 60, __ATOMIC_RELAXED, __HIP_MEMORY_SCOPE_AGENT), e61 = __hip_atomic_load(EX + 61, __ATOMIC_RELAXED, __HIP_MEMORY_SCOPE_AGENT), e62 = __hip_atomic_load(EX + 62, __ATOMIC_RELAXED, __HIP_MEMORY_SCOPE_AGENT);
                total += PROBE_P0SEL == 0 ? e61 - e60 : e62 - e61; } continue; }
            if (PROBE_SKEW == 5) { const unsigned* EX = (const unsigned*)(WSP() + WS_CTL + 768 * 1024); const unsigned e1 = __hip_atomic_load(EX + i, __ATOMIC_RELAXED, __HIP_MEMORY_SCOPE_AGENT), e0 = __hip_atomic_load(EX + (i == 0 ? 60 : i - 1), __ATOMIC_RELAXED, __HIP_MEMORY_SCOPE_AGENT); total += e1 - e0; continue; }
            if (PROBE_SKEW == 4) { const unsigned ex = __hip_atomic_load((const unsigned*)(WSP() + WS_CTL + 768 * 1024) + i, __ATOMIC_RELAXED, __HIP_MEMORY_SCOPE_AGENT); total += (unsigned)((int)(ex - base) - mx); continue; }
            total += PROBE_SKEW == 3 ? (unsigned)(xm / 32 - sm / 256) : PROBE_SKEW == 2 ? (unsigned)(mx - mn) : (unsigned)(mx - sm / 256); }
        const unsigned tk_ = total * PROBE_SKEW_AMP; const unsigned long long t0_ = __builtin_amdgcn_s_memrealtime(); while ((unsigned)(__builtin_amdgcn_s_memrealtime() - t0_) < tk_) __builtin_amdgcn_s_sleep(8); } }
#endif
}

extern "C" void kernel_launch(void* const* d_in, const int* in_sizes, int n_in, void* d_out, int out_size, void* d_ws, size_t ws_size, hipStream_t stream) {
    static int grid = 0;
    if (grid == 0) {
        if (n_in != 18 || in_sizes[0] != M * D || out_size != M * D || ws_size < WS_NEED) { fprintf(stderr, "kernel_launch: unexpected shapes: n_in %d in0 %d out %d ws %zu (need %zu)\n", n_in, n_in > 0 ? in_sizes[0] : -1, out_size, ws_size, (size_t)WS_NEED); grid = -1; return; }
        int dev = 0, cus = 0, per_cu = 0;
        if (hipGetDevice(&dev) != hipSuccess || hipDeviceGetAttribute(&cus, hipDeviceAttributeMultiprocessorCount, dev) != hipSuccess) { grid = -1; return; }
        if (hipFuncSetAttribute((const void*)mk_fwd, hipFuncAttributeMaxDynamicSharedMemorySize, LDS_BYTES) != hipSuccess) { fprintf(stderr, "kernel_launch: hipFuncSetAttribute failed\n"); grid = -1; return; }
        if (hipOccupancyMaxActiveBlocksPerMultiprocessor(&per_cu, (const void*)mk_fwd, NWAVES * 64, LDS_BYTES) != hipSuccess || per_cu < 1) { fprintf(stderr, "kernel_launch: occupancy query reports %d\n", per_cu); }
        (void)hipGetLastError();
        grid = cus;
    }
    if (grid < 0) return;
    if (hipMemsetAsync((char*)d_ws + WS_CTL, 0, CTL_ZERO_BYTES, stream) != hipSuccess) return;
    Args a{};
    for (int i = 0; i < 18; ++i) a.in[i] = (const float*)d_in[i];
    a.out = (float*)d_out; a.ws = (unsigned char*)d_ws;
    hipLaunchKernelGGL(mk_fwd, dim3(grid), dim3(NWAVES * 64), LDS_BYTES, stream, a);
}
```

```cpp
#include <hip/hip_runtime.h>
#include <cstdio>
#include <cstdint>
#ifndef PROBE_SKEW
#define PROBE_SKEW 0
#endif
#ifndef PROBE_SKEW_MASK
#define PROBE_SKEW_MASK 0xFFFFFFFFFFFFFFFFull
#endif
#ifndef PROBE_SKEW_AMP
#define PROBE_SKEW_AMP 2
#endif
#ifndef PROBE_EPI2
#define PROBE_EPI2 0
#endif
namespace pg8 {
#define PG8_LAS __attribute__((address_space(3)))
typedef unsigned short bf16_t;
typedef short bf16x8 __attribute__((ext_vector_type(8)));
typedef float f32x4 __attribute__((ext_vector_type(4)));
typedef unsigned u32x4 __attribute__((ext_vector_type(4)));
typedef int i32x4 __attribute__((ext_vector_type(4)));
constexpr int BM = 256, BK = 64, HALF = 128, HTB = HALF * BK * 2  , STAGE_BYTES = 8 * HTB, NXCD = 8, WGM = 8;

__host__ __device__ __forceinline__ int lds_byte(int r, int c) { const int st = (r >> 4) * 2 + (c >> 5), rr = r & 15, cc = c & 31, ob = rr * 64 + cc * 2; return st * 1024 + (ob ^ (((ob >> 9) & 1) << 5)); }
__host__ __device__ __forceinline__ void stage_rc(int b, int& R, int& C) { const int st = b / 1024, sb = b % 1024, swz = sb ^ (((sb >> 9) & 1) << 5); R = (st >> 1) * 16 + swz / 64; C = (st & 1) * 32 + (swz % 64) / 2; }
__host__ __device__ __forceinline__ int perm32(int rho) { const int n = rho >> 4, i = rho & 15; return 8 * (i >> 2) + 4 * n + (i & 3); }

struct Unit { int pm, pn; };
struct Gemm { const bf16_t* A; const bf16_t* Bt; int M, N, K; };

struct StaticOrder {
    int nM, nN, nwg, G, c, wave_id;
    __host__ __device__ void init(int M, int N, int G_, int c_) { nM = M / BM; nN = N / BM; nwg = nM * nN; G = G_; c = c_; }
    __host__ __device__ bool next(int i, Unit& u) const {
        const long L = (long)i * G + c; if (L >= nwg) return false;
        int wgid = (int)L; { const int q = nwg / NXCD, r = nwg % NXCD, xcd = wgid % NXCD, off = wgid / NXCD; wgid = (xcd < r ? xcd * (q + 1) : r * (q + 1) + (xcd - r) * q) + off; }
        const int nig = WGM * nN, gid = wgid / nig, fm = gid * WGM, gsz = (nM - fm) < WGM ? (nM - fm) : WGM;
        u.pm = fm + ((wgid % nig) % gsz); u.pn = (wgid % nig) / gsz; return true;
    }
    __device__ __forceinline__ void a_ready(const Unit&) const {}
    __device__ __forceinline__ void done(const Unit&) const {}
};

__device__ __forceinline__ unsigned cvt_pk_bf16(float lo, float hi) { unsigned r; asm volatile("v_cvt_pk_bf16_f32 %0, %1, %2" : "=v"(r) : "v"(lo), "v"(hi)); return r; }
typedef float f32x2 __attribute__((ext_vector_type(2)));
__device__ __forceinline__ float fsigmoid(float x) { return __builtin_amdgcn_rcpf(1.0f + __builtin_amdgcn_exp2f(-1.4426950408889634f * x)); }
__device__ __forceinline__ float fsilu(float x) { return x * fsigmoid(x); }
__device__ __forceinline__ u32x4 pack8(const f32x4 v0, const f32x4 v1) { u32x4 w; w.x = cvt_pk_bf16(v0[0], v0[1]); w.y = cvt_pk_bf16(v0[2], v0[3]); w.z = cvt_pk_bf16(v1[0], v1[1]); w.w = cvt_pk_bf16(v1[2], v1[3]); return w; }
__device__ __forceinline__ float bflo(unsigned w) { return __uint_as_float(w << 16); }
__device__ __forceinline__ float bfhi(unsigned w) { return __uint_as_float(w & 0xffff0000u); }

struct EpiStore {
    static constexpr bool PERM = true, AFTER_DRAIN = false, HEADSCALE = false;
    bf16_t* O; int ldc;
    __device__ __forceinline__ void operator()(const f32x4 (&acc)[2][2][4][2], const Unit& u, int wr, int wc, int fr, int fq) const {
        const int row0 = u.pm * BM + wr * 64 + fr, col0 = u.pn * BM + wc * 32 + 8 * fq;
#pragma unroll
        for (int ai = 0; ai < 2; ++ai)
#pragma unroll
            for (int m = 0; m < 4; ++m) { bf16_t* rowp = O + (size_t)(row0 + ai * HALF + m * 16) * ldc + col0;
#pragma unroll
                for (int bj = 0; bj < 2; ++bj) *(u32x4*)(rowp + bj * HALF) = pack8(acc[ai][bj][m][0], acc[ai][bj][m][1]); }
    }
};
template <int SH> struct EpiStoreS {
    static constexpr bool PERM = true, AFTER_DRAIN = false, HEADSCALE = false;
    bf16_t* O; int ldc;
    __device__ __forceinline__ void operator()(const f32x4 (&acc)[2][2][4][2], const Unit& u, int wr, int wc, int fr, int fq) const {
        int row0 = u.pm * BM + wr * 64 + fr, col0 = u.pn * BM + wc * 32 + 8 * fq; asm volatile("" : "+v"(row0), "+v"(col0));
        float s = 1.0f / (float)(1 << SH); asm volatile("" : "+v"(s));
#pragma unroll
        for (int ai = 0; ai < 2; ++ai)
#pragma unroll
            for (int m = 0; m < 4; ++m) { bf16_t* rowp = O + (size_t)(row0 + ai * HALF + m * 16) * ldc + col0;
#pragma unroll
                for (int bj = 0; bj < 2; ++bj) *(u32x4*)(rowp + bj * HALF) = pack8(acc[ai][bj][m][0] * s, acc[ai][bj][m][1] * s); }
    }
};
template <int SH, int O8SH = -1> struct EpiSwiGLUx;
typedef EpiSwiGLUx<0> EpiSwiGLU;
template <int SH, int O8SH> struct EpiSwiGLUx {
    static constexpr bool PERM = true, AFTER_DRAIN = false, HEADSCALE = false;
    bf16_t* O; int ldc;
    __device__ __forceinline__ void operator()(const f32x4 (&acc)[2][2][4][2], const Unit& u, int wr, int wc, int fr, int fq) const {
        int row0 = u.pm * BM + wr * 64 + fr, col0 = u.pn * HALF + wc * 32 + 8 * fq; if (SH != 0) asm volatile("" : "+v"(row0), "+v"(col0));
#pragma unroll
        for (int ai = 0; ai < 2; ++ai)
#pragma unroll
            for (int m = 0; m < 4; ++m) { bf16_t* rowp = O + (size_t)(row0 + ai * HALF + m * 16) * ldc + col0;
                f32x4 r0, r1;
#pragma unroll
                for (int j = 0; j < 4; ++j) {
                    float s1 = 1.0f / (float)(1 << SH), s2 = s1 * s1 * (O8SH >= 0 ? (float)(1 << (O8SH >= 0 ? O8SH : 0)) : 1.0f); if (SH != 0) asm volatile("" : "+v"(s1), "+v"(s2));
                    if (SH == 0) {
                    r0[j] = (acc[ai][0][m][0][j] * acc[ai][1][m][0][j]) * __builtin_amdgcn_rcpf(1.0f + __builtin_amdgcn_exp2f(-acc[ai][0][m][0][j]));
                    r1[j] = (acc[ai][0][m][1][j] * acc[ai][1][m][1][j]) * __builtin_amdgcn_rcpf(1.0f + __builtin_amdgcn_exp2f(-acc[ai][0][m][1][j])); } else {
                    r0[j] = (acc[ai][0][m][0][j] * acc[ai][1][m][0][j]) * (s2 * __builtin_amdgcn_rcpf(1.0f + __builtin_amdgcn_exp2f(-s1 * acc[ai][0][m][0][j])));
                    r1[j] = (acc[ai][0][m][1][j] * acc[ai][1][m][1][j]) * (s2 * __builtin_amdgcn_rcpf(1.0f + __builtin_amdgcn_exp2f(-s1 * acc[ai][0][m][1][j]))); } }
                if (O8SH >= 0) { int w0 = 0, w1 = 0;
                    w0 = __builtin_amdgcn_cvt_pk_fp8_f32(r0[0], r0[1], w0, false); w0 = __builtin_amdgcn_cvt_pk_fp8_f32(r0[2], r0[3], w0, true);
                    w1 = __builtin_amdgcn_cvt_pk_fp8_f32(r1[0], r1[1], w1, false); w1 = __builtin_amdgcn_cvt_pk_fp8_f32(r1[2], r1[3], w1, true);
                    typedef unsigned u32x2 __attribute__((ext_vector_type(2)));
                    *(u32x2*)((unsigned char*)O + (size_t)(row0 + ai * HALF + m * 16) * ldc + col0) = (u32x2){(unsigned)w0, (unsigned)w1}; }
                else __builtin_nontemporal_store(pack8(r0, r1), (u32x4*)rowp); }
    }
};
typedef EpiSwiGLUx<5, 2> EpiSwiGLU8o;
typedef EpiSwiGLUx<0, 2> EpiSwiGLU0o;
__device__ __forceinline__ void rope8(const f32x4 (&a0)[2], const f32x4 (&a1)[2], float p, const float (&invf)[2][4], float sc, f32x4 (&o1)[2], f32x4 (&o2)[2]) {
#pragma unroll
    for (int n = 0; n < 2; ++n)
#pragma unroll
        for (int j = 0; j < 4; ++j) { const float rev = __builtin_amdgcn_fractf(p * invf[n][j] * 0.15915494309189535f);
            const float s = __builtin_amdgcn_sinf(rev) * sc, c = __builtin_amdgcn_cosf(rev) * sc; const float x1 = a0[n][j], x2 = a1[n][j];
            o1[n][j] = x1 * c - x2 * s; o2[n][j] = x2 * c + x1 * s; }
}
struct EpiEvenIn {
    static constexpr bool PERM = true, AFTER_DRAIN = false, HEADSCALE = false;
    bf16_t* E; const int* pos;
    __device__ __forceinline__ void operator()(const f32x4 (&acc)[2][2][4][2], const Unit& u, int wr, int wc, int fr, int fq) const {
        const int row0 = u.pm * BM + wr * 64 + fr; constexpr int ldc = 2816;
        if (u.pn < 8 || (u.pn == 10 && wc >= 2)) {
            const int cb = (u.pn < 8) ? u.pn * BM + wc * 32 + 8 * fq : 2688 + 32 * (wc - 2) + 8 * fq; const int cs = (u.pn < 8) ? HALF : 64;
#pragma unroll
            for (int ai = 0; ai < 2; ++ai)
#pragma unroll
                for (int m = 0; m < 4; ++m) { bf16_t* rowp = E + (size_t)(row0 + ai * HALF + m * 16) * ldc + cb;
#pragma unroll
                    for (int bj = 0; bj < 2; ++bj) *(u32x4*)(rowp + bj * cs) = pack8(acc[ai][bj][m][0], acc[ai][bj][m][1]); }
        } else {
            const int cb = ((u.pn < 10) ? 2048 + (u.pn - 8) * BM + 64 * wc : 2560 + 64 * wc) + 8 * fq;
            float invf[2][4];
#pragma unroll
            for (int n = 0; n < 2; ++n)
#pragma unroll
                for (int j = 0; j < 4; ++j) invf[n][j] = __builtin_amdgcn_exp2f(-(float)(8 * fq + 4 * n + j) * (13.287712379549449f / 32.0f));
#pragma unroll
            for (int ai = 0; ai < 2; ++ai)
#pragma unroll
                for (int m = 0; m < 4; ++m) { const int row = row0 + ai * HALF + m * 16; const float p = (float)pos[row]; f32x4 o1[2], o2[2];
                    rope8(acc[ai][0][m], acc[ai][1][m], p, invf, 1.0f, o1, o2);
                    bf16_t* rowp = E + (size_t)row * ldc + cb; *(u32x4*)rowp = pack8(o1[0], o1[1]); *(u32x4*)(rowp + 32) = pack8(o2[0], o2[1]); }
        }
    }
};
struct EpiOddIn {
    static constexpr bool PERM = true, AFTER_DRAIN = false, HEADSCALE = false;
    bf16_t *Q, *K, *V, *G; const int* pos; const float* og;
    __device__ __forceinline__ void operator()(const f32x4 (&acc)[2][2][4][2], const Unit& u, int wr, int wc, int fr, int fq) const {
        const int row0 = u.pm * BM + wr * 64 + fr;
        if (u.pn < 8) {
            bf16_t* dst = (u.pn < 4) ? Q : K; const float sc = (u.pn < 4) ? 1.0f : 0.0625f; const int cb = (u.pn & 3) * BM + 32 * wc + 8 * fq;
            float invf[2][4];
#pragma unroll
            for (int n = 0; n < 2; ++n)
#pragma unroll
                for (int j = 0; j < 4; ++j) invf[n][j] = __builtin_amdgcn_exp2f(-(float)(32 * wc + 8 * fq + 4 * n + j) * (13.287712379549449f / 127.0f));
#pragma unroll
            for (int ai = 0; ai < 2; ++ai)
#pragma unroll
                for (int m = 0; m < 4; ++m) { const int row = row0 + ai * HALF + m * 16; const float p = (float)pos[row]; f32x4 o1[2], o2[2];
                    rope8(acc[ai][0][m], acc[ai][1][m], p, invf, sc, o1, o2);
                    bf16_t* rowp = dst + (size_t)row * 1024 + cb; *(u32x4*)rowp = pack8(o1[0], o1[1]); *(u32x4*)(rowp + HALF) = pack8(o2[0], o2[1]); }
        } else if (u.pn < 16) {
            const int cb = (u.pn - 8) * BM + wc * 32 + 8 * fq;
#pragma unroll
            for (int ai = 0; ai < 2; ++ai)
#pragma unroll
                for (int m = 0; m < 4; ++m) { bf16_t* rowp = V + (size_t)(row0 + ai * HALF + m * 16) * 2048 + cb;
#pragma unroll
                    for (int bj = 0; bj < 2; ++bj) *(u32x4*)(rowp + bj * HALF) = pack8(acc[ai][bj][m][0], acc[ai][bj][m][1]); }
        } else {
            const int cb = (u.pn - 16) * BM + wc * 32 + 8 * fq;
            f32x4 gv[2][2];
#pragma unroll
            for (int bj = 0; bj < 2; ++bj)
#pragma unroll
                for (int n = 0; n < 2; ++n) gv[bj][n] = *(const f32x4*)(og + ((cb + bj * HALF) & 511) + 4 * n);
#pragma unroll
            for (int ai = 0; ai < 2; ++ai)
#pragma unroll
                for (int m = 0; m < 4; ++m) { bf16_t* rowp = G + (size_t)(row0 + ai * HALF + m * 16) * 2048 + cb;
#pragma unroll
                    for (int bj = 0; bj < 2; ++bj) { f32x4 r0, r1;
#pragma unroll
                        for (int j = 0; j < 4; ++j) { r0[j] = fsilu(acc[ai][bj][m][0][j]) * gv[bj][0][j]; r1[j] = fsilu(acc[ai][bj][m][1][j]) * gv[bj][1][j]; }
                        *(u32x4*)(rowp + bj * HALF) = pack8(r0, r1); } }
        }
    }
};
struct EpiPleG {
    static constexpr bool PERM = true, AFTER_DRAIN = false, HEADSCALE = false;
    bf16_t* Z; const bf16_t* T; const float* rsi;
    __device__ __forceinline__ void operator()(const f32x4 (&acc)[2][2][4][2], const Unit& u, int wr, int wc, int fr, int fq) const {
        const int row0 = u.pm * BM + wr * 64 + fr, col0 = u.pn * BM + wc * 32 + 8 * fq;
#pragma unroll
        for (int ai = 0; ai < 2; ++ai)
#pragma unroll
            for (int m = 0; m < 4; ++m) { const size_t off = (size_t)(row0 + ai * HALF + m * 16) * 1024 + col0; const float s = rsi[row0 + ai * HALF + m * 16];
#pragma unroll
                for (int bj = 0; bj < 2; ++bj) { const u32x4 t = *(const u32x4*)(T + off + bj * HALF); f32x4 r0, r1;
                    r0[0] = fsigmoid(acc[ai][bj][m][0][0] * s) * bflo(t.x); r0[1] = fsigmoid(acc[ai][bj][m][0][1] * s) * bfhi(t.x); r0[2] = fsigmoid(acc[ai][bj][m][0][2] * s) * bflo(t.y); r0[3] = fsigmoid(acc[ai][bj][m][0][3] * s) * bfhi(t.y);
                    r1[0] = fsigmoid(acc[ai][bj][m][1][0] * s) * bflo(t.z); r1[1] = fsigmoid(acc[ai][bj][m][1][1] * s) * bfhi(t.z); r1[2] = fsigmoid(acc[ai][bj][m][1][2] * s) * bflo(t.w); r1[3] = fsigmoid(acc[ai][bj][m][1][3] * s) * bfhi(t.w);
                    *(u32x4*)(Z + off + bj * HALF) = pack8(r0, r1); } }
    }
};


struct EpiStoreHS {
    static constexpr bool PERM = true, AFTER_DRAIN = false, HEADSCALE = true;
    bf16_t* O; int ldc; const float* ssq;
    __device__ __forceinline__ void rescale(f32x4 (&acc)[2][2][4][2], const Unit& u, int wr, int fr, int hh) const {
        int row0 = u.pm * BM + wr * 64 + fr; asm volatile("" : "+v"(row0));
#pragma unroll
        for (int ai = 0; ai < 2; ++ai)
#pragma unroll
            for (int m = 0; m < 4; ++m) { const float* sp = ssq + (size_t)(row0 + ai * HALF + m * 16) * 4 + hh; const float a = sp[-1] * (1.0f / 512.0f) + 1e-6f, b = sp[0] * (1.0f / 512.0f) + 1e-6f;
                const float ratio = __builtin_amdgcn_sqrtf(b * __builtin_amdgcn_rcpf(a));
#pragma unroll
                for (int bj = 0; bj < 2; ++bj)
#pragma unroll
                    for (int n = 0; n < 2; ++n) acc[ai][bj][m][n] = acc[ai][bj][m][n] * ratio;
                asm volatile("" ::: "memory"); }
    }
    __device__ __forceinline__ void operator()(const f32x4 (&acc)[2][2][4][2], const Unit& u, int wr, int wc, int fr, int fq) const {
        int row0 = u.pm * BM + wr * 64 + fr, col0 = u.pn * BM + wc * 32 + 8 * fq; asm volatile("" : "+v"(row0), "+v"(col0));
#pragma unroll
        for (int ai = 0; ai < 2; ++ai)
#pragma unroll
            for (int m = 0; m < 4; ++m) { const int row = row0 + ai * HALF + m * 16; bf16_t* rowp = O + (size_t)row * ldc + col0; const float s = __builtin_amdgcn_rsqf(ssq[(size_t)row * 4 + 3] * (1.0f / 512.0f) + 1e-6f);
#pragma unroll
                for (int bj = 0; bj < 2; ++bj) *(u32x4*)(rowp + bj * HALF) = pack8(acc[ai][bj][m][0] * s, acc[ai][bj][m][1] * s);
                asm volatile("" ::: "memory"); }
    }
};
typedef int i32x8 __attribute__((ext_vector_type(8)));
template <bool F8> struct FragSel { typedef bf16x8 A[4][2]; typedef bf16x8 B[2][2]; };
template <> struct FragSel<true> { typedef i32x8 A[4]; typedef i32x8 B[2]; };
template <class Epi, class Sched, bool ALIGN_EPI = false, bool SP2 = false, bool DRY = false, int FP8 = 0>
__device__ __forceinline__ void gemm_phase(PG8_LAS unsigned char* lds, const Gemm g, const Sched& S, const Epi& E) {
    unsigned msk_ = ~0u; asm volatile("" : "+s"(msk_)); const int lane = (int)__builtin_amdgcn_mbcnt_hi(msk_, __builtin_amdgcn_mbcnt_lo(msk_, 0u));
    int wid = S.wave_id; asm volatile("" : "+s"(wid)); const int tid = wid * 64 + lane, wr = wid >> 2, wc = wid & 3, fr = lane & 15, fq = lane >> 4;
    const int K = g.K, nt = K / BK;
    unsigned voffA[2], voffB[2];
#pragma unroll
    for (int i = 0; i < 2; ++i) { int R, C; stage_rc(tid * 16 + i * 8192, R, C); const int Rb = (Epi::PERM && FP8 == 0) ? ((R & ~31) + perm32(R & 31)) : R;
        voffA[i] = (unsigned)(R * K + C) * 2u; voffB[i] = (unsigned)(Rb * K + C) * 2u; }
    const size_t kstep = (size_t)(BK * 2);
    const size_t hstep = (size_t)HALF * K * 2;
    const size_t tstep = 2 * hstep;
    const unsigned ldsw = (unsigned)wid * 1024u;
    const int aoff = lds_byte(wr * 64 + fr, fq * 8), boff = FP8 != 0 ? aoff + (wc * 4 - wr * 8) * 1024 : lds_byte(wc * 32 + fr, fq * 8);
#define PG8_CAT8(x, y) __builtin_shufflevector((i32x4)(x), (i32x4)(y), 0, 1, 2, 3, 4, 5, 6, 7)
#define PG8_SA(b, h) (((b) * 2 + (h)) * HTB)
#define PG8_SB(b, h) ((4 + (b) * 2 + (h)) * HTB)
#define PG8_STAGE(bufoff, gbase, voff) do { if constexpr (!DRY) { _Pragma("unroll") for (int _i = 0; _i < 2; ++_i) { if constexpr (FP8 != 0)   \
        __builtin_amdgcn_global_load_lds((const unsigned*)((const char*)(gbase) + (size_t)_i * 64 * (size_t)K * 2 + (voff)[0]), (PG8_LAS unsigned*)(lds + (bufoff) + ldsw + _i * 8192), 16, 0, 0); else \
        __builtin_amdgcn_global_load_lds((const unsigned*)((const char*)(gbase) + (voff)[_i]), (PG8_LAS unsigned*)(lds + (bufoff) + ldsw + _i * 8192), 16, 0, 0); } } } while (0)
#define PG8_LDA(dst, b, h) do { if constexpr (FP8 != 0) { _Pragma("unroll") for (int m = 0; m < 4; ++m) dst[m] = PG8_CAT8(*(const PG8_LAS bf16x8*)(lds + PG8_SA(b, h) + aoff + m * 2048), *(const PG8_LAS bf16x8*)(lds + PG8_SA(b, h) + aoff + m * 2048 + 1024)); } else { \
        _Pragma("unroll") for (int m = 0; m < 4; ++m) _Pragma("unroll") for (int k = 0; k < 2; ++k) dst[m][k] = *(const PG8_LAS bf16x8*)(lds + PG8_SA(b, h) + aoff + m * 2048 + k * 1024); } } while (0)
#define PG8_LDB(dst, b, h) do { if constexpr (FP8 != 0) { _Pragma("unroll") for (int n = 0; n < 2; ++n) dst[n] = PG8_CAT8(*(const PG8_LAS bf16x8*)(lds + PG8_SB(b, h) + boff + n * 2048), *(const PG8_LAS bf16x8*)(lds + PG8_SB(b, h) + boff + n * 2048 + 1024)); } else { \
        _Pragma("unroll") for (int n = 0; n < 2; ++n) _Pragma("unroll") for (int k = 0; k < 2; ++k) dst[n][k] = *(const PG8_LAS bf16x8*)(lds + PG8_SB(b, h) + boff + n * 2048 + k * 1024); } } while (0)
#define PG8_MMA(ai, bj, At, Bt) do { __builtin_amdgcn_s_setprio(1); if constexpr (FP8 != 0) { _Pragma("unroll") for (int m = 0; m < 4; ++m) _Pragma("unroll") for (int n = 0; n < 2; ++n) \
        asm volatile("v_mfma_f32_16x16x128_f8f6f4 %0, %1, %2, %0" : "+v"(acc[ai][bj][m][n]) : "v"(Bt[n]), "v"(At[m])); }     else { \
        _Pragma("unroll") for (int m = 0; m < 4; ++m) _Pragma("unroll") for (int n = 0; n < 2; ++n) _Pragma("unroll") for (int k = 0; k < 2; ++k) \
        acc[ai][bj][m][n] = __builtin_amdgcn_mfma_f32_16x16x32_bf16(Bt[n][k], At[m][k], acc[ai][bj][m][n], 0, 0, 0); } __builtin_amdgcn_s_setprio(0); } while (0)
#define PG8_WAIT_V(n) asm volatile("s_waitcnt vmcnt(" #n ")" ::: "memory")
#define PG8_WAIT_L(n) asm volatile("s_waitcnt lgkmcnt(" #n ")" ::: "memory")
#define PG8_BAR __builtin_amdgcn_s_barrier()
#define PG8_SCHED __builtin_amdgcn_sched_barrier(0)
    Unit cur, nxt; int ui = 0;
    if (!S.next(0, cur)) return;
    f32x4 acc[2][2][4][2];
#pragma unroll
    for (int a = 0; a < 2; ++a)
#pragma unroll
        for (int b = 0; b < 2; ++b)
#pragma unroll
            for (int m = 0; m < 4; ++m)
#pragma unroll
                for (int n = 0; n < 2; ++n) acc[a][b][m][n] = (f32x4){0.f, 0.f, 0.f, 0.f};
    typename FragSel<(FP8 != 0)>::A At; typename FragSel<(FP8 != 0)>::B B0, B1;
    const char* cA = (const char*)g.A + (size_t)cur.pm * tstep; const char* cB = (const char*)g.Bt + (size_t)cur.pn * tstep;
    S.a_ready(cur);
    if constexpr (SP2) {
        PG8_STAGE(PG8_SB(0, 0), cB, voffB); PG8_STAGE(PG8_SB(0, 1), cB + hstep, voffB); PG8_STAGE(PG8_SA(0, 0), cA, voffA); PG8_STAGE(PG8_SA(0, 1), cA + hstep, voffA);
        if (wr == 1) PG8_BAR;
        PG8_WAIT_V(2); PG8_BAR;
        PG8_STAGE(PG8_SB(1, 0), cB + kstep, voffB); PG8_STAGE(PG8_SA(1, 0), cA + kstep, voffA); PG8_STAGE(PG8_SB(1, 1), cB + hstep + kstep, voffB);
        PG8_WAIT_V(6); PG8_BAR;
    } else {
        PG8_STAGE(PG8_SB(0, 0), cB, voffB); PG8_STAGE(PG8_SA(0, 0), cA, voffA); PG8_STAGE(PG8_SB(0, 1), cB + hstep, voffB); PG8_STAGE(PG8_SA(0, 1), cA + hstep, voffA);
        if (wr == 1) PG8_BAR;
        PG8_WAIT_V(4); PG8_BAR;
        PG8_STAGE(PG8_SB(1, 0), cB + kstep, voffB); PG8_STAGE(PG8_SA(1, 0), cA + kstep, voffA); PG8_STAGE(PG8_SB(1, 1), cB + hstep + kstep, voffB);
        PG8_WAIT_V(6); PG8_BAR;
    }
    for (;;) {
        const bool has_next = S.next(ui + 1, nxt);
        const char* nA = has_next ? (const char*)g.A + (size_t)nxt.pm * tstep : cA; const char* nB = has_next ? (const char*)g.Bt + (size_t)nxt.pn * tstep : cB;
        const int tin = Epi::HEADSCALE ? 8 : nt;
        for (int tb = 0; tb < nt; tb += tin) {
        if constexpr (Epi::HEADSCALE) { if (tb != 0) E.rescale(acc, cur, wr, fr, tb >> 3); }
#pragma nounroll
        for (int t = tb; t < tb + tin; t += 2) {
            const bool last = (t == nt - 2);
            const char* a1 = cA + (size_t)(t + 1) * kstep;
            const char* a2 = last ? nA : cA + (size_t)(t + 2) * kstep; const char* b2 = last ? nB : cB + (size_t)(t + 2) * kstep;
            const char* a3 = a2 + kstep; const char* b3 = b2 + kstep;
            if (last && has_next) S.a_ready(nxt);
            if constexpr (SP2) {
            PG8_LDB(B0, 0, 0); PG8_LDB(B1, 0, 1); PG8_SCHED; PG8_LDA(At, 0, 0); PG8_STAGE(PG8_SA(1, 1), a1 + hstep, voffA);
            PG8_WAIT_V(8); PG8_WAIT_L(0); PG8_BAR; PG8_MMA(0, 0, At, B0); PG8_MMA(0, 1, At, B1); PG8_BAR; PG8_SCHED;
            PG8_LDA(At, 0, 1); PG8_STAGE(PG8_SB(0, 0), b2, voffB); PG8_STAGE(PG8_SB(0, 1), b2 + hstep, voffB); PG8_STAGE(PG8_SA(0, 0), a2, voffA);
            PG8_WAIT_V(8); PG8_WAIT_L(0); PG8_BAR; PG8_MMA(1, 0, At, B0); PG8_MMA(1, 1, At, B1); PG8_BAR; PG8_SCHED;
            PG8_LDB(B0, 1, 0); PG8_LDB(B1, 1, 1); PG8_SCHED; PG8_LDA(At, 1, 0); PG8_STAGE(PG8_SA(0, 1), a2 + hstep, voffA);
            PG8_WAIT_V(8); PG8_WAIT_L(0); PG8_BAR; PG8_MMA(0, 0, At, B0); PG8_MMA(0, 1, At, B1); PG8_BAR; PG8_SCHED;
            PG8_LDA(At, 1, 1); PG8_STAGE(PG8_SB(1, 0), b3, voffB); PG8_STAGE(PG8_SB(1, 1), b3 + hstep, voffB); PG8_STAGE(PG8_SA(1, 0), a3, voffA);
            PG8_WAIT_V(8); PG8_WAIT_L(0); PG8_BAR; PG8_MMA(1, 0, At, B0); PG8_MMA(1, 1, At, B1); PG8_BAR; PG8_SCHED;
            } else {
            PG8_LDB(B0, 0, 0); PG8_SCHED; PG8_LDA(At, 0, 0); PG8_STAGE(PG8_SA(1, 1), a1 + hstep, voffA);
            PG8_WAIT_L(8); PG8_BAR; PG8_WAIT_L(0); PG8_MMA(0, 0, At, B0); PG8_BAR; PG8_SCHED;
            PG8_LDB(B1, 0, 1); PG8_STAGE(PG8_SB(0, 0), b2, voffB);
            PG8_BAR; PG8_WAIT_L(0); PG8_MMA(0, 1, At, B1); PG8_BAR;
            PG8_LDA(At, 0, 1); PG8_STAGE(PG8_SA(0, 0), a2, voffA);
            PG8_BAR; PG8_WAIT_L(0); PG8_MMA(1, 0, At, B0); PG8_BAR; PG8_SCHED;
            PG8_STAGE(PG8_SB(0, 1), b2 + hstep, voffB);
            PG8_WAIT_V(6); PG8_BAR; PG8_MMA(1, 1, At, B1); PG8_BAR;
            PG8_LDB(B0, 1, 0); PG8_SCHED; PG8_LDA(At, 1, 0); PG8_STAGE(PG8_SA(0, 1), a2 + hstep, voffA);
            PG8_WAIT_L(8); PG8_BAR; PG8_WAIT_L(0); PG8_MMA(0, 0, At, B0); PG8_BAR; PG8_SCHED;
            PG8_LDB(B1, 1, 1); PG8_STAGE(PG8_SB(1, 0), b3, voffB);
            PG8_BAR; PG8_WAIT_L(0); PG8_MMA(0, 1, At, B1); PG8_BAR;
            PG8_LDA(At, 1, 1); PG8_STAGE(PG8_SA(1, 0), a3, voffA);
            PG8_BAR; PG8_WAIT_L(0); PG8_MMA(1, 0, At, B0); PG8_BAR; PG8_SCHED;
            PG8_STAGE(PG8_SB(1, 1), b3 + hstep, voffB);
            PG8_WAIT_V(6); PG8_BAR; PG8_MMA(1, 1, At, B1); PG8_BAR;
            }
        }
        }
        if constexpr (ALIGN_EPI) { if (wr == 0) PG8_BAR; }
        if constexpr (DRY) { _Pragma("unroll") for (int a = 0; a < 2; ++a) _Pragma("unroll") for (int b = 0; b < 2; ++b) _Pragma("unroll") for (int m = 0; m < 4; ++m) _Pragma("unroll") for (int n = 0; n < 2; ++n) asm volatile("" :: "v"(acc[a][b][m][n])); } else
        if constexpr (FP8 != 0) { unsigned m2_ = ~0u; asm volatile("" : "+s"(m2_)); const int l2_ = (int)__builtin_amdgcn_mbcnt_hi(m2_, __builtin_amdgcn_mbcnt_lo(m2_, 0u)); E(acc, cur, wr, wc, l2_ & 15, l2_ >> 4); S.done(cur); } else
        if constexpr (!Epi::AFTER_DRAIN) { E(acc, cur, wr, wc, fr, fq); if (PROBE_EPI2) { asm volatile("" ::: "memory"); E(acc, cur, wr, wc, fr, fq); } S.done(cur); }
        if (!has_next) break;
#pragma unroll
        for (int a = 0; a < 2; ++a)
#pragma unroll
            for (int b = 0; b < 2; ++b)
#pragma unroll
                for (int m = 0; m < 4; ++m)
#pragma unroll
                    for (int n = 0; n < 2; ++n) acc[a][b][m][n] = (f32x4){0.f, 0.f, 0.f, 0.f};
        cur = nxt; cA = nA; cB = nB; ++ui;
        if constexpr (ALIGN_EPI) { if (wr == 1) PG8_BAR; }
    }
    PG8_WAIT_V(0);
    if constexpr (!ALIGN_EPI) { if (wr == 0) PG8_BAR; }
    PG8_BAR;
    if constexpr (Epi::AFTER_DRAIN) { E.fused(acc, cur, wr, wc, fr, fq, lds, wid, lane); S.done(cur); }
#undef PG8_SA
#undef PG8_SB
#undef PG8_STAGE
#undef PG8_LDA
#undef PG8_LDB
#undef PG8_MMA
#undef PG8_CAT8
#undef PG8_WAIT_V
#undef PG8_WAIT_L
#undef PG8_BAR
#undef PG8_SCHED
}
}

#define GAS __attribute__((address_space(1)))
#define LAS __attribute__((address_space(3)))
typedef unsigned short bf16;
typedef unsigned v4u __attribute__((ext_vector_type(4)));
typedef float f32x4 __attribute__((ext_vector_type(4)));
typedef short bf16x8 __attribute__((ext_vector_type(8)));
typedef GAS unsigned gu32;
typedef GAS unsigned long long gu64;
#define RLX_AGENT __ATOMIC_RELAXED, __HIP_MEMORY_SCOPE_AGENT
#define LDS_WAIT() asm volatile("s_waitcnt lgkmcnt(0)" ::: "memory")
#define VM_WAIT() asm volatile("s_waitcnt vmcnt(0)" ::: "memory")
__device__ __forceinline__ unsigned long long rt() { return __builtin_amdgcn_s_memrealtime(); }
__device__ __forceinline__ unsigned f2bf(float f) { unsigned u = __builtin_bit_cast(unsigned, f); return (u + 0x7fffu + ((u >> 16) & 1u)) >> 16; }
__device__ __forceinline__ unsigned pk2(float lo, float hi) { return f2bf(lo) | (f2bf(hi) << 16); }

#define XB_TMO      128
#define XB_XCNT(j)  (256  + 64 * (j))
#define XB_XSUB(j)  (1280 + 64 * (j))
#define XB_XGEN(j)  (2304 + 64 * (j))
#define XB_TOP      3328
#define XB_TOPGEN   3392
#define XCD_BAR_WORDS 3456
#define XB_SPIN_CAP (1u << 22)

__device__ __forceinline__ unsigned xb_ld(unsigned* p)              { return __hip_atomic_load(p, __ATOMIC_RELAXED, __HIP_MEMORY_SCOPE_AGENT); }
__device__ __forceinline__ unsigned xb_add(unsigned* p, unsigned v) { return __hip_atomic_fetch_add(p, v, __ATOMIC_RELAXED, __HIP_MEMORY_SCOPE_AGENT); }
__device__ __forceinline__ unsigned xb_xcc_id() { return (unsigned)__builtin_amdgcn_s_getreg((3 << 11) | 20) & 0xFu; }
#define XB_SPIN(cond, bar) do { unsigned _sp = 0; while (cond) { __builtin_amdgcn_s_sleep(1); \
    if ((++_sp & 255u) == 0u) { if (xb_ld(&(bar)[XB_TMO])) break; if (_sp > XB_SPIN_CAP) { atomicAdd(&(bar)[XB_TMO], 1u); break; } } } } while (0)

struct XcdBarrier {
    unsigned* bar; unsigned x; int wv;
    volatile LAS unsigned* st;
#if PROBE_SKEW
    unsigned* ts;
#endif
};

__device__ __forceinline__ XcdBarrier xcd_barrier_post(unsigned* bar, volatile LAS unsigned* st) {
    XcdBarrier b; b.bar = bar; b.x = xb_xcc_id(); b.st = st;
    if (threadIdx.x == 0) (void)xb_add(&bar[XB_XCNT(b.x)], 1u);
    return b;
}
__device__ __forceinline__ void xcd_barrier_complete(unsigned* bar, unsigned x, unsigned& nloc, unsigned& nx) {
    const unsigned G = gridDim.x * gridDim.y * gridDim.z;
    unsigned sum, cnt, mine, sp = 0u;
    for (;;) {
        sum = 0u; cnt = 0u; mine = 0u;
#pragma unroll
        for (unsigned j = 0; j < 16; ++j) { const unsigned c = xb_ld(&bar[XB_XCNT(j)]); sum += c; cnt += (c > 0u) ? 1u : 0u; mine = (j == x) ? c : mine; }
        if (sum == G) break;
        __builtin_amdgcn_s_sleep(1);
        if ((++sp & 255u) == 0u) { if (xb_ld(&bar[XB_TMO])) break; if (sp > XB_SPIN_CAP) { atomicAdd(&bar[XB_TMO], 1u); break; } }
    }
    nloc = mine > 0u ? mine : 1u; nx = cnt > 0u ? cnt : 1u;
}

__device__ __forceinline__ void xcd_barrier(const XcdBarrier& b) {
    asm volatile("s_waitcnt vmcnt(0)" ::: "memory");
    __syncthreads();
    unsigned xm_ = ~0u; asm volatile("" : "+s"(xm_));
    if (b.wv == 0 && __builtin_amdgcn_mbcnt_hi(xm_, __builtin_amdgcn_mbcnt_lo(xm_, 0u)) == 0u) {
        unsigned* bar = b.bar; asm volatile("" : "+s"(bar));
#if PROBE_SKEW
        *b.ts = (unsigned)__builtin_amdgcn_s_memrealtime();
#endif
        __builtin_amdgcn_s_waitcnt(0);
        unsigned nloc = b.st[0], nx = b.st[1];
        if (nloc == 0u) { xcd_barrier_complete(bar, b.x, nloc, nx); b.st[0] = nloc; b.st[1] = nx; }
        const unsigned old = xb_add(&bar[XB_XSUB(b.x)], 1u);
        const unsigned gen = old / nloc;
        if (old + 1u == (gen + 1u) * nloc) {
            __builtin_amdgcn_fence(__ATOMIC_RELEASE, "agent");
            asm volatile("s_waitcnt vmcnt(0)" ::: "memory");
            const unsigned og = xb_add(&bar[XB_TOP], 1u);
            const unsigned tg = og / nx;
            if (og + 1u == (tg + 1u) * nx) xb_add(&bar[XB_TOPGEN], 1u);
            else XB_SPIN(xb_ld(&bar[XB_TOPGEN]) == tg, bar);
            __builtin_amdgcn_fence(__ATOMIC_ACQUIRE, "agent");
            xb_add(&bar[XB_XGEN(b.x)], 1u);
            asm volatile("s_waitcnt vmcnt(0)" ::: "memory");
        } else {
            XB_SPIN(xb_ld(&bar[XB_XGEN(b.x)]) == gen, bar);
            __builtin_amdgcn_fence(__ATOMIC_ACQUIRE, "agent");
            asm volatile("s_waitcnt vmcnt(0)" ::: "memory");
        }
    }
    __syncthreads();
}

typedef unsigned v2u __attribute__((ext_vector_type(2)));
constexpr int NWAVES = 8;
constexpr int BATCH = 8, SEQ = 8192, D = 1024, FF = 2816, PLE = 256, DEPTH = 2;
constexpr int M = BATCH * SEQ;
constexpr int EVEN_IN = 2816, ODD_IN = 6144;
constexpr float EPS = 1e-6f;
constexpr size_t MiB = 1u << 20;
constexpr size_t WS_CTL = 0, CTL_ZERO_BYTES = 2 * MiB;
constexpr size_t WS_SSQ = 1 * MiB;
constexpr size_t WS_WB = 2 * MiB;
constexpr size_t W_LAYER = 71 * MiB / 2;
constexpr size_t WO_1IN = 0, WO_1OUT = 11 * MiB, WO_2IN = WO_1OUT + 11 * MiB / 2, WO_2OUT = WO_2IN + 11 * MiB, WO_PROJ = WO_2OUT + 11 * MiB / 2, WO_GATE = WO_PROJ + MiB / 2;
static_assert(WO_GATE + 2 * MiB == W_LAYER, "weight map");
constexpr size_t WS_WEVIN = WS_WB + 2 * W_LAYER, WS_WEVOUT = WS_WEVIN + 11 * MiB / 2, WS_WODIN = WS_WEVOUT + 2 * MiB, WS_WODOUT = WS_WODIN + 12 * MiB, WS_WEND = WS_WODOUT + 4 * MiB;
constexpr size_t WS_YN = 98 * MiB;
static_assert(WS_WEND <= WS_YN, "weights fit");
constexpr size_t WS_BIG = WS_YN + 128 * MiB;
constexpr size_t WS_END = WS_BIG + 768 * MiB;
constexpr size_t BIG_ACT = 0, BIG_E = 0, BIG_OAB = 352 * MiB, BIG_SCR = 480 * MiB, BIG_SEGL = 480 * MiB, BIG_SEGD = 496 * MiB;
constexpr size_t BIG_Q = 0, BIG_K = 128 * MiB, BIG_V = 256 * MiB, BIG_G = 512 * MiB;
constexpr size_t BIG_Z = 0, BIG_PB = 352 * MiB, BIG_T = 384 * MiB;
constexpr size_t WS_RS = WS_END;
constexpr size_t WS_NEED = WS_RS + MiB;
constexpr int CW_BAR = 4096;
constexpr int RING_OFF = 0, RING_BYTES = 131072;
constexpr int LDSCTL_OFF = 146944, MISC_OFF = LDSCTL_OFF + 320;
constexpr int LDS_BYTES = 147456;

struct Frame {
    LAS unsigned char* lds;
    int wave, vcu, G;
};
__device__ __forceinline__ int hw_lane() { unsigned m = ~0u; asm volatile("" : "+s"(m)); return (int)__builtin_amdgcn_mbcnt_hi(m, __builtin_amdgcn_mbcnt_lo(m, 0u)); }

__device__ __forceinline__ float wave_sum(float v) {
#pragma unroll
    for (int o = 1; o < 64; o <<= 1) v += __shfl_xor(v, o);
    return v;
}
__device__ __forceinline__ float wave_max(float v) {
#pragma unroll
    for (int o = 1; o < 64; o <<= 1) v = fmaxf(v, __shfl_xor(v, o));
    return v;
}
__device__ __forceinline__ float bf2f(bf16 b) { return __uint_as_float(((unsigned)b) << 16); }
__device__ __forceinline__ float blo(unsigned w) { return __uint_as_float(w << 16); }
__device__ __forceinline__ float bhi(unsigned w) { return __uint_as_float(w & 0xffff0000u); }
__device__ __forceinline__ float fsig(float x) { return 1.0f / (1.0f + __expf(-x)); }
__device__ __forceinline__ float fsg(float x) { return __builtin_amdgcn_rcpf(1.0f + __builtin_amdgcn_exp2f(-1.4426950408889634f * x)); }
__device__ __forceinline__ void unpack8(const v4u w, float (&f)[8]) { f[0] = blo(w.x); f[1] = bhi(w.x); f[2] = blo(w.y); f[3] = bhi(w.y); f[4] = blo(w.z); f[5] = bhi(w.z); f[6] = blo(w.w); f[7] = bhi(w.w); }
__device__ __forceinline__ v4u pack8f(const float (&f)[8]) { v4u w; w.x = pk2(f[0], f[1]); w.y = pk2(f[2], f[3]); w.z = pk2(f[4], f[5]); w.w = pk2(f[6], f[7]); return w; }

__device__ __forceinline__ void transpose_item(const float* W, int K, int Nsrc, bf16* WT, int dr0, int sc0, int k0, LAS float* scr, int lane, const float* gk, float cs) {
    const float gv = (gk ? gk[k0 + lane] : 1.0f) * cs;
    float wv[32];
#pragma unroll
    for (int i = 0; i < 32; ++i) wv[i] = W[(size_t)(k0 + 2 * i + (lane >> 5)) * Nsrc + sc0 + (lane & 31)];
#pragma unroll
    for (int i = 0; i < 32; ++i) { const int kk = 2 * i + (lane >> 5); scr[kk * 33 + (lane & 31)] = wv[i] * __shfl(gv, kk); }
    LDS_WAIT(); asm volatile("" ::: "memory");
    const int c = lane & 7;
#pragma unroll
    for (int j = 0; j < 4; ++j) { const int n = (lane >> 3) + 8 * j; const LAS float* s = scr + (8 * c) * 33 + n;
        v4u o; o.x = pk2(s[0 * 33], s[1 * 33]); o.y = pk2(s[2 * 33], s[3 * 33]); o.z = pk2(s[4 * 33], s[5 * 33]); o.w = pk2(s[6 * 33], s[7 * 33]);
        *(GAS v4u*)(WT + (size_t)(dr0 + n) * K + k0 + 8 * c) = o; }
    LDS_WAIT(); asm volatile("" ::: "memory");
}
__device__ __forceinline__ int ffn_src_col(int n0) { const int pn = n0 >> 8, bj = (n0 >> 7) & 1, w = n0 & 127; return bj * FF + 128 * pn + w; }
__device__ __forceinline__ int even_src_col(int n0) {
    const int pn = n0 >> 8; if (pn < 8) return n0;
    const int bj = (n0 >> 7) & 1, wc = (n0 >> 5) & 3;
    if (pn < 10) return 256 * pn + 64 * wc + 32 * bj;
    if (wc < 2) return 2560 + 64 * wc + 32 * bj;
    return 2688 + 64 * bj + 32 * (wc - 2);
}
#ifndef PROBE_P0WG
#define PROBE_P0WG 0
#endif
#ifndef PROBE_P0SEL
#define PROBE_P0SEL 0
#endif
#ifndef P0_PAIR
#define P0_PAIR 0
#endif
#ifndef P0_BAL
#define P0_BAL 1
#endif
template <int MAP> __device__ __forceinline__ void conv_matrix(Frame& F, const float* W, int K, int N, bf16* WT, LAS float* scr, int& base, const float* gk = nullptr) {
    int lane = hw_lane();
    int gw = F.vcu * NWAVES + F.wave, NGW = F.G * NWAVES; asm volatile("" : "+s"(gw), "+s"(NGW)); const int nblk = N / 32, nitems = (K / 64) * nblk;
    int it0 = gw - (P0_BAL ? base : 0); if (it0 < 0) it0 += NGW; base = (base + nitems) % NGW;
    for (int it = it0; it < nitems; it += NGW) { const int kb = it / nblk, nb = it % nblk, n0 = 32 * nb;
        const int sc0 = MAP == 0 ? n0 : (MAP == 1 ? ffn_src_col(n0) : even_src_col(n0));
        const float cs = MAP == 1 ? (((n0 >> 7) & 1) ? 0.6931471805599453f : 1.4426950408889634f) : 1.0f;
        transpose_item(W, K, N, WT, n0, sc0, 64 * kb, scr, lane, gk, cs); }
}
template <int MAP> __device__ __forceinline__ void conv_matrix_fp8(Frame& F, const float* W, int K, int N, unsigned char* WT, LAS float* scr, const float* gk, float sh, int* basep = nullptr) {
    int lane = hw_lane();
    int gw = F.vcu * NWAVES + F.wave, NGW = F.G * NWAVES; asm volatile("" : "+s"(gw), "+s"(NGW)); const int nblk = N / 32, nitems = (K / 64) * nblk;
    int it0 = gw; if (basep) { it0 = gw - *basep; if (it0 < 0) it0 += NGW; *basep = (*basep + nitems) % NGW; }
    for (int it = it0; it < nitems; it += NGW) { const int kb = it / nblk, nb = it % nblk, n0 = 32 * nb, k0 = 64 * kb;
        const int sc0 = MAP == 0 ? n0 : (MAP == 1 ? ffn_src_col(n0) : even_src_col(n0));
        const float cs = (MAP == 1 ? (((n0 >> 7) & 1) ? 0.6931471805599453f : 1.4426950408889634f) : 1.0f) * sh;
        const float gv = (gk ? gk[k0 + lane] : 1.0f) * cs;
        float wv[32];
#pragma unroll
        for (int i = 0; i < 32; ++i) wv[i] = W[(size_t)(k0 + 2 * i + (lane >> 5)) * N + sc0 + (lane & 31)];
#pragma unroll
        for (int i = 0; i < 32; ++i) { const int kk = 2 * i + (lane >> 5); scr[kk * 33 + (lane & 31)] = wv[i] * __shfl(gv, kk); }
        LDS_WAIT(); asm volatile("" ::: "memory");
        const int c = lane & 7;
#pragma unroll
        for (int j = 0; j < 4; ++j) { const int n = (lane >> 3) + 8 * j; const LAS float* sp = scr + (8 * c) * 33 + pg8::perm32(n); int w0 = 0, w1 = 0;
            w0 = __builtin_amdgcn_cvt_pk_fp8_f32(sp[0 * 33], sp[1 * 33], w0, false); w0 = __builtin_amdgcn_cvt_pk_fp8_f32(sp[2 * 33], sp[3 * 33], w0, true);
            w1 = __builtin_amdgcn_cvt_pk_fp8_f32(sp[4 * 33], sp[5 * 33], w1, false); w1 = __builtin_amdgcn_cvt_pk_fp8_f32(sp[6 * 33], sp[7 * 33], w1, true);
            *(GAS v2u*)(WT + (size_t)(n0 + n) * K + k0 + 8 * c) = (v2u){(unsigned)w0, (unsigned)w1}; }
        LDS_WAIT(); asm volatile("" ::: "memory"); }
}
template <int MAP> __device__ __forceinline__ void conv_item_cols(int n0, int& sc0, float& cs) {
    sc0 = MAP == 0 ? n0 : (MAP == 1 ? ffn_src_col(n0) : even_src_col(n0)); cs = MAP == 1 ? (((n0 >> 7) & 1) ? 0.6931471805599453f : 1.4426950408889634f) : 1.0f; }
__device__ __forceinline__ void conv_finish(const float (&wv)[32], float gv, bf16* WT, int K, int dr0, int k0, LAS float* scr, int lane) {
#pragma unroll
    for (int i = 0; i < 32; ++i) { const int kk = 2 * i + (lane >> 5); scr[kk * 33 + (lane & 31)] = wv[i] * __shfl(gv, kk); }
    LDS_WAIT(); asm volatile("" ::: "memory");
    const int c = lane & 7;
#pragma unroll
    for (int j = 0; j < 4; ++j) { const int n = (lane >> 3) + 8 * j; const LAS float* s = scr + (8 * c) * 33 + n;
        v4u o; o.x = pk2(s[0 * 33], s[1 * 33]); o.y = pk2(s[2 * 33], s[3 * 33]); o.z = pk2(s[4 * 33], s[5 * 33]); o.w = pk2(s[6 * 33], s[7 * 33]);
        *(GAS v4u*)(WT + (size_t)(dr0 + n) * K + k0 + 8 * c) = o; }
    LDS_WAIT(); asm volatile("" ::: "memory");
}
template <int MAPA, int MAPB> __device__ __forceinline__ void conv_pair(Frame& F, const float* WA, int KA, int NA, bf16* TA, const float* gA, const float* WB, int KB, int NB, bf16* TB, const float* gB, LAS float* scr, int& base) {
    int lane = hw_lane();
    int gw = F.vcu * NWAVES + F.wave, NGW = F.G * NWAVES; asm volatile("" : "+s"(gw), "+s"(NGW));
    const int nblkA = NA / 32, nitA = (KA / 64) * nblkA, nblkB = NB / 32, nitB = (KB / 64) * nblkB;
    int ia = gw - base; if (ia < 0) ia += NGW; base = (base + nitA) % NGW;
    int ib = gw - base; if (ib < 0) ib += NGW; base = (base + nitB) % NGW;
    for (; ia < nitA || ib < nitB; ia += NGW, ib += NGW) {
        const bool onA = ia < nitA, onB = ib < nitB;
        float wa[32], wb[32], gva = 1.0f, gvb = 1.0f; int scA = 0, scB = 0, k0A = 0, k0B = 0, n0A = 0, n0B = 0; float csA = 1.0f, csB = 1.0f;
        if (onA) { const int kb = ia / nblkA, nb = ia % nblkA; n0A = 32 * nb; k0A = 64 * kb; conv_item_cols<MAPA>(n0A, scA, csA); gva = (gA ? gA[k0A + lane] : 1.0f) * csA;
#pragma unroll
            for (int i = 0; i < 32; ++i) wa[i] = WA[(size_t)(k0A + 2 * i + (lane >> 5)) * NA + scA + (lane & 31)]; }
        if (onB) { const int kb = ib / nblkB, nb = ib % nblkB; n0B = 32 * nb; k0B = 64 * kb; conv_item_cols<MAPB>(n0B, scB, csB); gvb = (gB ? gB[k0B + lane] : 1.0f) * csB;
#pragma unroll
            for (int i = 0; i < 32; ++i) wb[i] = WB[(size_t)(k0B + 2 * i + (lane >> 5)) * NB + scB + (lane & 31)]; }
        if (onA) conv_finish(wa, gva, TA, KA, n0A, k0A, scr, lane);
        if (onB) conv_finish(wb, gvb, TB, KB, n0B, k0B, scr, lane);
    }
}

__device__ __forceinline__ void load_g16(const float* g, int lane, float (&o)[16]) {
#pragma unroll
    for (int j = 0; j < 2; ++j) { const f32x4 a = *(const f32x4*)(g + 8 * lane + 512 * j), b = *(const f32x4*)(g + 8 * lane + 512 * j + 4);
        o[8 * j + 0] = a.x; o[8 * j + 1] = a.y; o[8 * j + 2] = a.z; o[8 * j + 3] = a.w; o[8 * j + 4] = b.x; o[8 * j + 5] = b.y; o[8 * j + 6] = b.z; o[8 * j + 7] = b.w; }
}
__device__ __forceinline__ void load_h16(const float* hrow, int lane, float (&o)[16]) { load_g16(hrow, lane, o); }
__device__ __forceinline__ void store_h16(float* hrow, int lane, const float (&o)[16]) {
#pragma unroll
    for (int j = 0; j < 2; ++j) { *(f32x4*)(hrow + 8 * lane + 512 * j) = (f32x4){o[8 * j], o[8 * j + 1], o[8 * j + 2], o[8 * j + 3]}; *(f32x4*)(hrow + 8 * lane + 512 * j + 4) = (f32x4){o[8 * j + 4], o[8 * j + 5], o[8 * j + 6], o[8 * j + 7]}; }
}
__device__ __forceinline__ void store_b16(bf16* row, int lane, const float (&o)[16]) {
#pragma unroll
    for (int j = 0; j < 2; ++j) { v4u w; w.x = pk2(o[8 * j], o[8 * j + 1]); w.y = pk2(o[8 * j + 2], o[8 * j + 3]); w.z = pk2(o[8 * j + 4], o[8 * j + 5]); w.w = pk2(o[8 * j + 6], o[8 * j + 7]); *(v4u*)(row + 8 * lane + 512 * j) = w; }
}
#ifndef INIT_PF
#define INIT_PF 0
#endif
__device__ __forceinline__ void init_rows(Frame& F, const float* x, bf16* HB, float* RS) {
    int lane = hw_lane();
    int gw = F.vcu * NWAVES + F.wave, NGW = F.G * NWAVES; asm volatile("" : "+s"(gw), "+s"(NGW));
    float hn[16]; if (INIT_PF && gw < M) load_h16(x + (size_t)gw * D, lane, hn);
    for (int m = gw; m < M; m += NGW) { float h[16];
        if (INIT_PF) {
#pragma unroll
            for (int i = 0; i < 16; ++i) h[i] = hn[i];
            const int mn = m + NGW < M ? m + NGW : m; load_h16(x + (size_t)mn * D, lane, hn);
        } else load_h16(x + (size_t)m * D, lane, h);
        float s = 0.f;
#pragma unroll
        for (int i = 0; i < 16; ++i) s += h[i] * h[i];
        s = wave_sum(s) * (1.0f / D) + EPS; const float rstd = rsqrtf(s);
#pragma unroll
        for (int i = 0; i < 16; ++i) h[i] *= rstd;
        store_b16(HB + (size_t)m * D, lane, h);
        if (lane == 0) RS[m] = s * rstd; }
}
#ifndef THIN_NT
#define THIN_NT 3
#endif
#define THIN_LDY(p) ((THIN_NT & 1) ? __builtin_nontemporal_load((const v4u*)(p)) : *(const v4u*)(p))
__device__ __forceinline__ void store_h16_nt(float* hrow, int lane, const float (&o)[16]) {
#pragma unroll
    for (int j = 0; j < 2; ++j) { __builtin_nontemporal_store((f32x4){o[8 * j], o[8 * j + 1], o[8 * j + 2], o[8 * j + 3]}, (f32x4*)(hrow + 8 * lane + 512 * j)); __builtin_nontemporal_store((f32x4){o[8 * j + 4], o[8 * j + 5], o[8 * j + 6], o[8 * j + 7]}, (f32x4*)(hrow + 8 * lane + 512 * j + 4)); }
}
template <bool FINAL, bool CONV_P>
__device__ __forceinline__ void thin_pass(Frame& F, bf16* HB, const bf16* Y, const float* gA, float c, float* RS, float* outf, const float* psrc, bf16* PBo, bf16* HBo = nullptr, unsigned char* HB8 = nullptr) {
    int lane = hw_lane();
    int gw = F.vcu * NWAVES + F.wave, NGW = F.G * NWAVES; asm volatile("" : "+s"(gw), "+s"(NGW));
    float ga[16]; load_g16(gA, lane, ga);
    v4u yw[2], hw[2], yn[2], hn[2]; f32x4 pv, pn;
#pragma unroll
    for (int j = 0; j < 2; ++j) { yw[j] = THIN_LDY(Y + (size_t)gw * D + 8 * lane + 512 * j); hw[j] = *(const v4u*)(HB + (size_t)gw * D + 8 * lane + 512 * j); }
    if (CONV_P) pv = *(const f32x4*)(psrc + (size_t)gw * PLE + 4 * lane);
    float rcur = RS[gw];
    for (int m = gw; m < M; m += NGW) {
        const int mn = (m + NGW < M) ? m + NGW : m;
        const float rnext = RS[mn];
#pragma unroll
        for (int j = 0; j < 2; ++j) { yn[j] = THIN_LDY(Y + (size_t)mn * D + 8 * lane + 512 * j); hn[j] = *(const v4u*)(HB + (size_t)mn * D + 8 * lane + 512 * j); }
        if (CONV_P) pn = *(const f32x4*)(psrc + (size_t)mn * PLE + 4 * lane);
        float y[16], h[16];
#pragma unroll
        for (int j = 0; j < 2; ++j) { const v4u w = yw[j]; const v4u hh = hw[j];
            y[8 * j + 0] = blo(w.x); y[8 * j + 1] = bhi(w.x); y[8 * j + 2] = blo(w.y); y[8 * j + 3] = bhi(w.y); y[8 * j + 4] = blo(w.z); y[8 * j + 5] = bhi(w.z); y[8 * j + 6] = blo(w.w); y[8 * j + 7] = bhi(w.w);
            h[8 * j + 0] = blo(hh.x); h[8 * j + 1] = bhi(hh.x); h[8 * j + 2] = blo(hh.y); h[8 * j + 3] = bhi(hh.y); h[8 * j + 4] = blo(hh.z); h[8 * j + 5] = bhi(hh.z); h[8 * j + 6] = blo(hh.w); h[8 * j + 7] = bhi(hh.w); }
        float s = 0.f;
#pragma unroll
        for (int i = 0; i < 16; ++i) s += y[i] * y[i];
        const float rstd = rsqrtf(wave_sum(s) * (1.0f / D) + EPS) * c;
#pragma unroll
        for (int i = 0; i < 16; ++i) h[i] = h[i] * rcur + y[i] * rstd * ga[i];
        rcur = rnext;
        if (FINAL) { if (THIN_NT & 2) store_h16_nt(outf + (size_t)m * D, lane, h); else store_h16(outf + (size_t)m * D, lane, h); }
        else { float s2 = 0.f;
#pragma unroll
            for (int i = 0; i < 16; ++i) s2 += h[i] * h[i];
            s2 = wave_sum(s2) * (1.0f / D) + EPS; const float r2 = rsqrtf(s2);
#pragma unroll
            for (int i = 0; i < 16; ++i) h[i] *= r2;
            store_b16((HBo ? HBo : HB) + (size_t)m * D, lane, h);
            if (HB8) {
#pragma unroll
                for (int j = 0; j < 2; ++j) { int w0 = 0, w1 = 0;
                    w0 = __builtin_amdgcn_cvt_pk_fp8_f32(h[8 * j + 0], h[8 * j + 1], w0, false); w0 = __builtin_amdgcn_cvt_pk_fp8_f32(h[8 * j + 2], h[8 * j + 3], w0, true);
                    w1 = __builtin_amdgcn_cvt_pk_fp8_f32(h[8 * j + 4], h[8 * j + 5], w1, false); w1 = __builtin_amdgcn_cvt_pk_fp8_f32(h[8 * j + 6], h[8 * j + 7], w1, true);
                    *(v2u*)(HB8 + (size_t)m * D + 8 * lane + 512 * j) = (v2u){(unsigned)w0, (unsigned)w1}; } }
            if (lane == 0 && !HBo) RS[m] = s2 * r2; }
        if (CONV_P) { *(unsigned long long*)(PBo + (size_t)m * PLE + 4 * lane) = (unsigned long long)pk2(pv.x, pv.y) | ((unsigned long long)pk2(pv.z, pv.w) << 32); pv = pn; }
#pragma unroll
        for (int j = 0; j < 2; ++j) { yw[j] = yn[j]; hw[j] = hn[j]; }
    }
}

__device__ __forceinline__ void naive_hgrn2(Frame& F, const bf16* E, const float* hgrn_lb, float* SCR) {
    int lane = hw_lane(); int gw = F.vcu * NWAVES + F.wave, NGW = F.G * NWAVES; asm volatile("" : "+s"(gw), "+s"(NGW)); const int gw_unused_ = 0;
    for (int unit = gw; unit < 256; unit += NGW) {
        const int b = unit >> 5, h = (unit >> 3) & 3, vg = unit & 7;
        const float lb0 = fsig(hgrn_lb[h * 128 + lane] - hgrn_lb[512 + h * 128 + lane]), lb1 = fsig(hgrn_lb[h * 128 + 64 + lane] - hgrn_lb[512 + h * 128 + 64 + lane]);
        float s0[16], s1[16];
#pragma unroll
        for (int j = 0; j < 16; ++j) { s0[j] = 0.f; s1[j] = 0.f; }
        const bf16* e = E + (size_t)b * SEQ * EVEN_IN; float* so = SCR + (size_t)b * SEQ * 512 + h * 128 + vg * 16;
        for (int t = 0; t < SEQ; ++t, e += EVEN_IN, so += 512) {
            float q0 = bf2f(e[h * 128 + lane]), q1 = bf2f(e[h * 128 + 64 + lane]);
            const float fl0 = bf2f(e[512 + h * 128 + lane]), fl1 = bf2f(e[512 + h * 128 + 64 + lane]);
            q0 = q0 * fsig(q0); q1 = q1 * fsig(q1);
            const float f0 = lb0 + (1.0f - lb0) * fsig(fl0), f1 = lb1 + (1.0f - lb1) * fsig(fl1), k0 = 1.0f - f0, k1 = 1.0f - f1;
            float v[16]; { float t8[8]; unpack8(*(const v4u*)(e + 1024 + h * 128 + vg * 16), t8);
#pragma unroll
                for (int j = 0; j < 8; ++j) v[j] = t8[j];
                unpack8(*(const v4u*)(e + 1024 + h * 128 + vg * 16 + 8), t8);
#pragma unroll
                for (int j = 0; j < 8; ++j) v[8 + j] = t8[j]; }
            float myo = 0.f;
#pragma unroll
            for (int j = 0; j < 16; ++j) { s0[j] = f0 * s0[j] + k0 * v[j]; s1[j] = f1 * s1[j] + k1 * v[j]; const float o = wave_sum(q0 * s0[j] + q1 * s1[j]); if (lane == j) myo = o; }
            if (lane < 16) so[lane] = myo;
        }
    }
}
__device__ __forceinline__ void hgrn_norm(Frame& F, const float* SCR, const bf16* E, const float* og, bf16* OAB) {
    int lane = hw_lane(); int gw = F.vcu * NWAVES + F.wave, NGW = F.G * NWAVES; asm volatile("" : "+s"(gw), "+s"(NGW)); const int gw_unused_ = 0;
    const float g0 = og[lane], g1 = og[64 + lane];
    for (int u = gw; u < M * 4; u += NGW) { const int row = u >> 2, h = u & 3;
        const float o0 = SCR[(size_t)row * 512 + h * 128 + lane], o1 = SCR[(size_t)row * 512 + h * 128 + 64 + lane];
        const float rstd = rsqrtf(wave_sum(o0 * o0 + o1 * o1) * (1.0f / 128.0f) + EPS);
        const float a0 = bf2f(E[(size_t)row * EVEN_IN + 1536 + h * 128 + lane]), a1 = bf2f(E[(size_t)row * EVEN_IN + 1536 + h * 128 + 64 + lane]);
        OAB[(size_t)row * D + h * 128 + lane] = (bf16)f2bf(o0 * rstd * g0 * a0 * fsig(a0)); OAB[(size_t)row * D + h * 128 + 64 + lane] = (bf16)f2bf(o1 * rstd * g1 * a1 * fsig(a1)); }
}
__device__ __forceinline__ void naive_swa(Frame& F, const bf16* E, const float* sinks, bf16* OAB) {
    int lane = hw_lane(); int gw = F.vcu * NWAVES + F.wave, NGW = F.G * NWAVES; asm volatile("" : "+s"(gw), "+s"(NGW)); const int gw_unused_ = 0;
    for (int unit = gw; unit < M * 8; unit += NGW) {
        const int row = unit >> 3, hq = unit & 7, g = hq >> 2, t = row & (SEQ - 1);
        float q[64];
#pragma unroll
        for (int i = 0; i < 8; ++i) { float t8[8]; unpack8(*(const v4u*)(E + (size_t)row * EVEN_IN + 2048 + hq * 64 + 8 * i), t8);
#pragma unroll
            for (int j = 0; j < 8; ++j) q[8 * i + j] = t8[j]; }
        float sc[2];
#pragma unroll
        for (int kk = 0; kk < 2; ++kk) { const int jt = t - 127 + lane + 64 * kk; const bool valid = jt >= 0; const int jr = valid ? jt : 0;
            const bf16* kp = E + (size_t)(row - t + jr) * EVEN_IN + 2560 + g * 64; float dot = 0.f;
#pragma unroll
            for (int i = 0; i < 8; ++i) { float t8[8]; unpack8(*(const v4u*)(kp + 8 * i), t8);
#pragma unroll
                for (int j = 0; j < 8; ++j) dot += q[8 * i + j] * t8[j]; }
            sc[kk] = valid ? dot * 0.125f : -__builtin_inff(); }
        const float sink = sinks[hq];
        const float mx = fmaxf(wave_max(fmaxf(sc[0], sc[1])), sink);
        const float p0 = __expf(sc[0] - mx), p1 = __expf(sc[1] - mx);
        const float denom = wave_sum(p0 + p1) + __expf(sink - mx);
        float o = 0.f;
        for (int j = 0; j < 128; ++j) { const int jt = t - 127 + j; const float pj = __shfl(j < 64 ? p0 : p1, j & 63);
            if (jt >= 0) o += pj * bf2f(E[(size_t)(row - t + jt) * EVEN_IN + 2688 + g * 64 + lane]); }
        OAB[(size_t)row * D + 512 + hq * 64 + lane] = (bf16)f2bf(o / denom);
    }
}
__device__ __forceinline__ void naive_retention(Frame& F, const bf16* Q, const bf16* K, bf16* V, float* SSQ) {
    int lane = hw_lane(); int gw = F.vcu * NWAVES + F.wave, NGW = F.G * NWAVES; asm volatile("" : "+s"(gw), "+s"(NGW)); const int gw_unused_ = 0;
    for (int unit = gw; unit < 2048; unit += NGW) {
        const int b = unit >> 8, h = (unit >> 6) & 3, v8 = unit & 63;
        const float gamma = 1.0f - exp2f(-5.0f - (float)h);
        float s[4][8];
#pragma unroll
        for (int i = 0; i < 4; ++i)
#pragma unroll
            for (int j = 0; j < 8; ++j) s[i][j] = 0.f;
        for (int t = 0; t < SEQ; ++t) { const size_t row = (size_t)b * SEQ + t;
            float q[4], k[4];
#pragma unroll
            for (int i = 0; i < 4; ++i) { q[i] = bf2f(Q[row * 1024 + h * 256 + lane + 64 * i]); k[i] = bf2f(K[row * 1024 + h * 256 + lane + 64 * i]); }
            float v[8]; unpack8(*(const v4u*)(V + row * 2048 + h * 512 + v8 * 8), v);
            float o[8]; float ss = 0.f;
#pragma unroll
            for (int j = 0; j < 8; ++j) { float a = 0.f;
#pragma unroll
                for (int i = 0; i < 4; ++i) { s[i][j] = gamma * s[i][j] + k[i] * v[j]; a += q[i] * s[i][j]; }
                o[j] = wave_sum(a); ss += o[j] * o[j]; }
            if (lane == 0) { *(v4u*)(V + row * 2048 + h * 512 + v8 * 8) = pack8f(o); atomicAdd(SSQ + row * 4 + h, ss); }
        }
    }
}
template <bool DRY> __device__ __forceinline__ void ret_norm(Frame& F, bf16* V, const bf16* G, const float* SSQ) {
    int lane = hw_lane(); int gw = F.vcu * NWAVES + F.wave, NGW = F.G * NWAVES; asm volatile("" : "+s"(gw), "+s"(NGW)); const int gw_unused_ = 0;
    for (int m = gw; m < M; m += NGW) {
#pragma unroll
        for (int j = 0; j < 4; ++j) { const float rstd = rsqrtf(SSQ[(size_t)m * 4 + j] * (1.0f / 512.0f) + EPS);
            float o[8], g[8]; unpack8(*(const v4u*)(V + (size_t)m * 2048 + 512 * j + 8 * lane), o); unpack8(*(const v4u*)(G + (size_t)m * 2048 + 512 * j + 8 * lane), g);
#pragma unroll
            for (int i = 0; i < 8; ++i) o[i] = o[i] * rstd * g[i];
            if (!DRY) *(v4u*)(V + (size_t)m * 2048 + 512 * j + 8 * lane) = pack8f(o); else { const v4u t_ = pack8f(o); asm volatile("" :: "v"(t_.x), "v"(t_.y), "v"(t_.z), "v"(t_.w)); } }
    }
}

typedef short s16x4 __attribute__((ext_vector_type(4)));
typedef float f32x2_t __attribute__((ext_vector_type(2))); typedef __bf16 bf16x2_t __attribute__((ext_vector_type(2)));
__device__ __forceinline__ unsigned cvtpk(float lo, float hi) { f32x2_t v = {lo, hi}; bf16x2_t b = __builtin_convertvector(v, bf16x2_t); return __builtin_bit_cast(unsigned, b); }
__device__ __forceinline__ s16x4 vtr(const LAS unsigned char* p) { return __builtin_bit_cast(s16x4, __builtin_amdgcn_ds_read_tr16_b64_v4i16((LAS s16x4*)p)); }
__device__ __forceinline__ bf16x8 trpair(const LAS unsigned char* p0, const LAS unsigned char* p1) { const s16x4 a = vtr(p0), b = vtr(p1); return (bf16x8){a[0], a[1], a[2], a[3], b[0], b[1], b[2], b[3]}; }
__device__ __forceinline__ bf16x8 pack_acc2(const f32x4 a, const f32x4 b) { v4u w; w.x = cvtpk(a[0], a[1]); w.y = cvtpk(a[2], a[3]); w.z = cvtpk(b[0], b[1]); w.w = cvtpk(b[2], b[3]); return __builtin_bit_cast(bf16x8, w); }
#define MFMA16(a, b, c) __builtin_amdgcn_mfma_f32_16x16x32_bf16((a), (b), (c), 0, 0, 0)
#define LBAR() do { asm volatile("s_waitcnt lgkmcnt(0)" ::: "memory"); __builtin_amdgcn_s_barrier(); asm volatile("" ::: "memory"); } while (0)

constexpr int R_KS = 528, R_VS = 144;
#ifndef RET_KSTG
#define RET_KSTG 1
#endif
constexpr int R_KT = 0, R_KSTG = 128 * R_KS;
static_assert(R_KSTG + 8 * 32 * 272 <= 146944, "R0 LDS map");
constexpr int R_VT0 = 0, R_VT1 = 128 * R_VS, R_ST0 = 2 * 128 * R_VS, R_ST1 = R_ST0 + 64 * R_KS, R_END = R_ST1 + 64 * R_KS, R_PK = R_END;
__device__ __forceinline__ void ret_att_phase(Frame& F, const bf16* Q, const bf16* K, bf16x8* ATT, bf16* KDT) {
    int w = F.wave; asm volatile("" : "+s"(w)); const int lane = hw_lane(), tid = w * 64 + lane, g = lane >> 4, r16 = lane & 15, q4 = r16 >> 2, p4 = r16 & 3;
    LAS unsigned char* const lds = F.lds;
    const int ct = w < 4 ? w : 11 - w;
    for (int unit = F.vcu; unit < 2048; unit += F.G) {
        const int bh = unit >> 6, n = unit & 63, b = bh >> 2, h = bh & 3;
        const float lg2 = __builtin_log2f(1.0f - __builtin_amdgcn_exp2f(-5.0f - (float)h));
        const size_t r0 = (size_t)b * SEQ + (size_t)n * 128;
        const bf16* Kg = K + (r0 + (tid >> 5)) * 1024 + h * 256 + (tid & 31) * 8;
        v4u Kr[8]; bf16x8 Qf[8];
#pragma unroll
        for (int i = 0; i < 8; ++i) Kr[i] = *(const v4u*)(Kg + (size_t)i * 16 * 1024);
#pragma unroll
        for (int ks = 0; ks < 8; ++ks) Qf[ks] = *(const bf16x8*)(Q + (r0 + 16 * ct + r16) * 1024 + h * 256 + 8 * g + 32 * ks);
        LBAR();
#pragma unroll
        for (int i = 0; i < 8; ++i) *(LAS v4u*)(lds + R_KT + ((tid >> 5) + 16 * i) * R_KS + (tid & 31) * 16) = Kr[i];
        LBAR();
        f32x4 at[8];
#pragma unroll
        for (int st = 0; st < 8; ++st) { at[st] = (f32x4){0.f, 0.f, 0.f, 0.f};
            if (st <= ct) {
#pragma unroll
                for (int ks = 0; ks < 8; ++ks) { const bf16x8 a = *(const LAS bf16x8*)(lds + R_KT + (16 * st + r16) * R_KS + (32 * ks + 8 * g) * 2); at[st] = MFMA16(a, Qf[ks], at[st]); }
#pragma unroll
                for (int r = 0; r < 4; ++r) { const int d = 16 * ct + r16 - (16 * st + 4 * g + r); at[st][r] = d >= 0 ? at[st][r] * __builtin_amdgcn_exp2f((float)d * lg2) : 0.f; }
            } }
#pragma unroll
        for (int sp = 0; sp < 4; ++sp) if (2 * sp <= ct) ATT[(((size_t)unit * 8 + ct) * 4 + sp) * 64 + lane] = pack_acc2(at[2 * sp], at[2 * sp + 1]);
        bf16* Ko = KDT + (size_t)unit * 256 * 128;
#pragma unroll
        for (int kt = 0; kt < 2; ++kt)
#pragma unroll
            for (int sb = 0; sb < 8; ++sb) { const int s0 = 16 * sb + 4 * g;
                const s16x4 t4 = vtr(lds + R_KT + (s0 + q4) * R_KS + (32 * w + 16 * kt + 4 * p4) * 2);
                float f0 = bf2f((bf16)t4[0]) * __builtin_amdgcn_exp2f((float)(127 - s0) * lg2), f1 = bf2f((bf16)t4[1]) * __builtin_amdgcn_exp2f((float)(126 - s0) * lg2);
                float f2 = bf2f((bf16)t4[2]) * __builtin_amdgcn_exp2f((float)(125 - s0) * lg2), f3 = bf2f((bf16)t4[3]) * __builtin_amdgcn_exp2f((float)(124 - s0) * lg2);
                v2u o2; o2.x = cvtpk(f0, f1); o2.y = cvtpk(f2, f3);
                if (RET_KSTG) *(LAS v2u*)(lds + R_KSTG + w * (32 * 272) + (16 * kt + r16) * 272 + s0 * 2) = o2;
                else *(v2u*)(Ko + (size_t)(32 * w + 16 * kt + r16) * 128 + s0) = o2; }
        if (RET_KSTG) {
#pragma unroll
            for (int i = 0; i < 8; ++i) { const int o = (i * 64 + lane) * 16; const v4u o4 = *(const LAS v4u*)(lds + R_KSTG + w * (32 * 272) + (o >> 8) * 272 + (o & 255));
                *(v4u*)(Ko + (size_t)(32 * w) * 128 + (o >> 1)) = o4; } }
    }
    LBAR();
}
#ifndef RET_PF
#define RET_PF 0
#endif
#ifndef RET_KEARLY
#define RET_KEARLY 1
#endif
#ifndef RET_PARK
#define RET_PARK 0
#endif
#ifndef RET_INPLACE
#define RET_INPLACE 0
#endif
#ifndef RET_INPLACE_K
#define RET_INPLACE_K 0
#endif
#ifndef RET_OSTG
#define RET_OSTG 1
#endif
#ifndef RET_VAR
#define RET_VAR 0
#endif
#ifndef RET_ASMST
#define RET_ASMST 0
#endif
__device__ __forceinline__ void st16_asm(void* p, const v4u v) { asm volatile("global_store_dwordx4 %0, %1, off\n\ts_nop 1" :: "v"(p), "v"(v) : "memory"); }
__device__ __forceinline__ void atomic_addf_asm(float* p, float v) { asm volatile("global_atomic_add_f32 %0, %1, off" :: "v"(p), "v"(v) : "memory"); }
template <bool DRY> __device__ __forceinline__ void ret_phase(Frame& F, const bf16* Q, const bf16* KDT, bf16* V, const bf16* G, const bf16x8* ATT, float* SSQ) {
    int w = F.wave; asm volatile("" : "+s"(w));
    LAS unsigned char* const lds = F.lds;
    for (int unit = F.vcu; unit < 256; unit += F.G) {
        const int lane = hw_lane(), tid = w * 64 + lane, g = lane >> 4, r16 = lane & 15, q4 = r16 >> 2, p4 = r16 & 3;
        const int bh = unit >> 3, vs = unit & 7, b = bh >> 2, h = bh & 3;
        const int ct = w < 4 ? w : 11 - w;
        const float lg2 = __builtin_log2f(1.0f - __builtin_amdgcn_exp2f(-5.0f - (float)h));
        const float dec_chunk = __builtin_amdgcn_exp2f(128.0f * lg2), qscale = __builtin_amdgcn_exp2f((float)(16 * ct + r16 + 1) * lg2);
        f32x4 Sacc[2][4];
#pragma unroll
        for (int kt = 0; kt < 2; ++kt)
#pragma unroll
            for (int vt = 0; vt < 4; ++vt) Sacc[kt][vt] = (f32x4){0.f, 0.f, 0.f, 0.f};
        const bf16* Qg = Q + (size_t)b * SEQ * 1024 + h * 256 + (size_t)(16 * ct + r16) * 1024 + 8 * g;
        const bf16* Kt = KDT + (size_t)bh * 64 * 256 * 128 + (size_t)(32 * w + r16) * 128 + 8 * g;
        bf16* Vg = V + (size_t)b * SEQ * 2048 + h * 512 + vs * 64;
        const bf16* Gu = G + (size_t)b * SEQ * 2048 + h * 512 + vs * 64; const unsigned goff = (unsigned)((16 * ct + r16) * 2048 + 4 * g) * 2u;
#define Gg ((const bf16*)((const char*)Gu + goff))
        const unsigned vldoff = (unsigned)((tid >> 3) * 2048 + (tid & 7) * 8) * 2u;
#define Vld ((const bf16*)((const char*)Vg + vldoff))
        const bf16x8* Ag = ATT + (((size_t)bh * 64 * 8 + ct) * 4) * 64 + lane;
        v4u Vr[2]; bf16x8 Qf[8], Kf[2][4], Af[4]; f32x4 otp[4]; v2u gvp[4]; unsigned pf = 0u;
#pragma unroll
        for (int vt = 0; vt < 4; ++vt) { otp[vt] = (f32x4){0.f, 0.f, 0.f, 0.f}; gvp[vt] = (v2u){0u, 0u}; }
        LBAR();
#pragma unroll
        for (int i = 0; i < 2; ++i) { const v4u v0 = *(const v4u*)(Vld + (size_t)i * 64 * 2048); *(LAS v4u*)(lds + R_VT0 + ((tid >> 3) + 64 * i) * R_VS + (tid & 7) * 16) = v0; Vr[i] = *(const v4u*)(Vld + (size_t)(128 + i * 64) * 2048); }
#pragma unroll
        for (int kt = 0; kt < 2; ++kt)
#pragma unroll
            for (int vt = 0; vt < 4; ++vt) { unsigned z_ = 0u; asm volatile("" : "+v"(z_));
                *(LAS v2u*)(lds + R_ST0 + (16 * vt + r16) * R_KS + (32 * w + 16 * kt + 4 * g) * 2) = (v2u){z_, z_}; }
#pragma unroll
        for (int ks = 0; ks < 8; ++ks) Qf[ks] = *(const bf16x8*)(Qg + 32 * ks);
#pragma unroll
        for (int kt = 0; kt < 2; ++kt)
#pragma unroll
            for (int ss = 0; ss < 4; ++ss) Kf[kt][ss] = *(const bf16x8*)(Kt + kt * 16 * 128 + 32 * ss);
#pragma unroll
        for (int sp = 0; sp < 4; ++sp) if (2 * sp <= ct) Af[sp] = Ag[sp * 64];
        LBAR();
        for (int n = 0; n < 64; ++n) {
            const int cur = n & 1; const int vt_cur = cur ? R_VT1 : R_VT0, vt_alt = cur ? R_VT0 : R_VT1, st_cur = cur ? R_ST1 : R_ST0, st_alt = cur ? R_ST0 : R_ST1;
            if (!RET_ASMST || DRY) asm volatile("" :: "v"(Af[0]), "v"(Kf[1][3]), "v"(Qf[7]), "v"(Vr[1]), "v"(gvp[3]), "v"(pf));
            if (n > 0) { const size_t row = (size_t)(n - 1) * 128 + 16 * ct + r16; float ss = 0.f;
              if (RET_PARK) {
#pragma unroll
                  for (int vt = 0; vt < 4; ++vt) otp[vt] = *(const LAS f32x4*)(lds + R_PK + vt * 8192 + tid * 16); }
#pragma unroll
              for (int vt = 0; vt < 4; ++vt) { v2u o2; o2.x = cvtpk(otp[vt][0] * blo(gvp[vt].x), otp[vt][1] * bhi(gvp[vt].x)); o2.y = cvtpk(otp[vt][2] * blo(gvp[vt].y), otp[vt][3] * bhi(gvp[vt].y));
                  if (RET_OSTG) *(LAS v2u*)(lds + R_PK + w * 2304 + r16 * 144 + (16 * vt + 4 * g) * 2) = o2;
                  else if (!DRY) *(v2u*)(Vg + row * 2048 + 16 * vt + 4 * g) = o2; else asm volatile("" :: "v"(o2.x), "v"(o2.y));
                  ss += (otp[vt][0] * otp[vt][0] + otp[vt][1] * otp[vt][1]) + (otp[vt][2] * otp[vt][2] + otp[vt][3] * otp[vt][3]); }
              if (RET_OSTG) {
#pragma unroll
                  for (int i = 0; i < 2; ++i) { const v4u o4 = *(const LAS v4u*)(lds + R_PK + w * 2304 + (8 * i + (lane >> 3)) * 144 + (lane & 7) * 16);
                      if (!DRY) { if (RET_ASMST) st16_asm(Vg + ((size_t)(n - 1) * 128 + 16 * ct + 8 * i + (lane >> 3)) * 2048 + (lane & 7) * 8, o4); else *(v4u*)(Vg + ((size_t)(n - 1) * 128 + 16 * ct + 8 * i + (lane >> 3)) * 2048 + (lane & 7) * 8) = o4; } else asm volatile("" :: "v"(o4.x), "v"(o4.y), "v"(o4.z), "v"(o4.w)); } }
              ss += __shfl_xor(ss, 16); ss += __shfl_xor(ss, 32);
              if (g == 0 && !DRY) { if (RET_ASMST) atomic_addf_asm(SSQ + ((size_t)b * SEQ + row) * 4 + h, ss); else atomicAdd(SSQ + ((size_t)b * SEQ + row) * 4 + h, ss); } if (DRY) asm volatile("" :: "v"(ss)); }
            if (n + 1 < 64) {
#pragma unroll
                for (int i = 0; i < 2; ++i) *(LAS v4u*)(lds + vt_alt + ((tid >> 3) + 64 * i) * R_VS + (tid & 7) * 16) = Vr[i];
            }
            if (RET_PF && n + 2 < 64 && w < 3) {
                const bf16* pp = w == 0 ? Q + (size_t)b * SEQ * 1024 + ((size_t)(n + 2) * 128 + vs * 16 + (lane >> 2)) * 1024 + h * 256 + (lane & 3) * 64
                               : w == 1 ? KDT + ((size_t)bh * 64 + (n + 2)) * 256 * 128 + (size_t)(vs * 64 + lane) * 64
                                        : (const bf16*)ATT + ((size_t)bh * 64 + (n + 2)) * 16384 + (size_t)(vs * 32 + (lane & 31)) * 64;
                pf = *(const unsigned*)pp; }
            v2u gv[4];
#pragma unroll
            for (int vt = 0; vt < 4; ++vt) gv[vt] = (DRY && RET_VAR >= 2) ? gvp[vt] : *(const v2u*)(Gg + (size_t)n * 128 * 2048 + 16 * vt);
            if (n + 2 < 64 && !(DRY && RET_VAR >= 2)) {
#pragma unroll
                for (int i = 0; i < 2; ++i) Vr[i] = *(const v4u*)(Vld + ((size_t)(n + 2) * 128 + i * 64) * 2048);
            }
#pragma unroll
            for (int kt = 0; kt < 2; ++kt)
#pragma unroll
                for (int vt = 0; vt < 4; ++vt) Sacc[kt][vt] = Sacc[kt][vt] * dec_chunk;
#pragma unroll
            for (int ss = 0; ss < 4; ++ss) {
#pragma unroll
                for (int vt = 0; vt < 4; ++vt) { const LAS unsigned char* p = lds + vt_cur + (32 * ss + 8 * g + q4) * R_VS + (16 * vt + 4 * p4) * 2; const bf16x8 bv = trpair(p, p + 4 * R_VS);
#pragma unroll
                    for (int kt = 0; kt < 2; ++kt) Sacc[kt][vt] = MFMA16(Kf[kt][ss], bv, Sacc[kt][vt]); }
                if (RET_INPLACE_K && n + 1 < 64 && !(DRY && RET_VAR >= 1)) {
                    __builtin_amdgcn_sched_barrier(0);
#pragma unroll
                    for (int kt = 0; kt < 2; ++kt) Kf[kt][ss] = *(const bf16x8*)(Kt + (size_t)(n + 1) * 256 * 128 + kt * 16 * 128 + 32 * ss);
                    __builtin_amdgcn_sched_barrier(0); } }
#pragma unroll
            for (int kt = 0; kt < 2; ++kt)
#pragma unroll
                for (int vt = 0; vt < 4; ++vt) { v2u s2; s2.x = cvtpk(Sacc[kt][vt][0], Sacc[kt][vt][1]); s2.y = cvtpk(Sacc[kt][vt][2], Sacc[kt][vt][3]);
                    *(LAS v2u*)(lds + st_alt + (16 * vt + r16) * R_KS + (32 * w + 16 * kt + 4 * g) * 2) = s2; }
            if (!RET_INPLACE_K && RET_KEARLY && n + 1 < 64 && !(DRY && RET_VAR >= 1)) {
                __builtin_amdgcn_sched_barrier(0);
#pragma unroll
                for (int kt = 0; kt < RET_KEARLY; ++kt)
#pragma unroll
                    for (int ss = 0; ss < 4; ++ss) Kf[kt][ss] = *(const bf16x8*)(Kt + (size_t)(n + 1) * 256 * 128 + kt * 16 * 128 + 32 * ss);
                __builtin_amdgcn_sched_barrier(0);
            }
            f32x4 ot[4];
#pragma unroll
            for (int vt = 0; vt < 4; ++vt) ot[vt] = (f32x4){0.f, 0.f, 0.f, 0.f};
            {
              bf16x8 sa[2][4];
#pragma unroll
              for (int vt = 0; vt < 4; ++vt) sa[0][vt] = *(const LAS bf16x8*)(lds + st_cur + (16 * vt + r16) * R_KS + (8 * g) * 2);
#pragma unroll
              for (int ks = 0; ks < 8; ++ks) {
                  if (ks + 1 < 8) {
#pragma unroll
                      for (int vt = 0; vt < 4; ++vt) sa[(ks + 1) & 1][vt] = *(const LAS bf16x8*)(lds + st_cur + (16 * vt + r16) * R_KS + (32 * (ks + 1) + 8 * g) * 2); }
                  __builtin_amdgcn_sched_barrier(0);
#pragma unroll
                  for (int vt = 0; vt < 4; ++vt) ot[vt] = MFMA16(sa[ks & 1][vt], Qf[ks], ot[vt]);
                  __builtin_amdgcn_sched_barrier(0);
                  if (RET_INPLACE && n + 1 < 64 && !(DRY && RET_VAR >= 1)) { Qf[ks] = *(const bf16x8*)(Qg + (size_t)(n + 1) * 128 * 1024 + 32 * ks); __builtin_amdgcn_sched_barrier(0); }
              } }
#pragma unroll
            for (int vt = 0; vt < 4; ++vt) ot[vt] = ot[vt] * qscale;
            if (n + 1 < 64 && !(DRY && RET_VAR >= 1)) {
                if (!RET_INPLACE) {
#pragma unroll
                for (int ks = 0; ks < 8; ++ks) Qf[ks] = *(const bf16x8*)(Qg + (size_t)(n + 1) * 128 * 1024 + 32 * ks); }
                if (!RET_INPLACE_K) {
#pragma unroll
                for (int kt = RET_KEARLY; kt < 2; ++kt)
#pragma unroll
                    for (int ss = 0; ss < 4; ++ss) Kf[kt][ss] = *(const bf16x8*)(Kt + (size_t)(n + 1) * 256 * 128 + kt * 16 * 128 + 32 * ss);
                }
            }
#pragma unroll
            for (int sp = 0; sp < 4; ++sp) if (2 * sp <= ct) {
#pragma unroll
                for (int vt = 0; vt < 4; ++vt) { const LAS unsigned char* p = lds + vt_cur + (32 * sp + 4 * g + q4) * R_VS + (16 * vt + 4 * p4) * 2;
                    ot[vt] = MFMA16(trpair(p, p + 16 * R_VS), Af[sp], ot[vt]); }
                if (RET_INPLACE && n + 1 < 64 && !(DRY && RET_VAR >= 1)) { __builtin_amdgcn_sched_barrier(0); Af[sp] = Ag[((size_t)(n + 1) * 32 + sp) * 64]; __builtin_amdgcn_sched_barrier(0); } }
            if (!RET_INPLACE && n + 1 < 64 && !(DRY && RET_VAR >= 1)) {
#pragma unroll
                for (int sp = 0; sp < 4; ++sp) if (2 * sp <= ct) Af[sp] = Ag[((size_t)(n + 1) * 32 + sp) * 64];
            }
#pragma unroll
            for (int vt = 0; vt < 4; ++vt) { if (RET_PARK) *(LAS f32x4*)(lds + R_PK + vt * 8192 + tid * 16) = ot[vt]; else otp[vt] = ot[vt]; gvp[vt] = gv[vt]; }
            LBAR();
        }
        { const size_t row = (size_t)63 * 128 + 16 * ct + r16; float ss = 0.f;
          if (RET_PARK) {
#pragma unroll
              for (int vt = 0; vt < 4; ++vt) otp[vt] = *(const LAS f32x4*)(lds + R_PK + vt * 8192 + tid * 16); }
#pragma unroll
          for (int vt = 0; vt < 4; ++vt) { v2u o2; o2.x = cvtpk(otp[vt][0] * blo(gvp[vt].x), otp[vt][1] * bhi(gvp[vt].x)); o2.y = cvtpk(otp[vt][2] * blo(gvp[vt].y), otp[vt][3] * bhi(gvp[vt].y));
              if (RET_OSTG) *(LAS v2u*)(lds + R_PK + w * 2304 + r16 * 144 + (16 * vt + 4 * g) * 2) = o2;
              else if (!DRY) *(v2u*)(Vg + row * 2048 + 16 * vt + 4 * g) = o2; else asm volatile("" :: "v"(o2.x), "v"(o2.y));
              ss += (otp[vt][0] * otp[vt][0] + otp[vt][1] * otp[vt][1]) + (otp[vt][2] * otp[vt][2] + otp[vt][3] * otp[vt][3]); }
          if (RET_OSTG) {
#pragma unroll
              for (int i = 0; i < 2; ++i) { const v4u o4 = *(const LAS v4u*)(lds + R_PK + w * 2304 + (8 * i + (lane >> 3)) * 144 + (lane & 7) * 16);
                  if (!DRY) *(v4u*)(Vg + ((size_t)63 * 128 + 16 * ct + 8 * i + (lane >> 3)) * 2048 + (lane & 7) * 8) = o4; else asm volatile("" :: "v"(o4.x), "v"(o4.y), "v"(o4.z), "v"(o4.w)); } }
          ss += __shfl_xor(ss, 16); ss += __shfl_xor(ss, 32);
          if (g == 0 && !DRY) atomicAdd(SSQ + ((size_t)b * SEQ + row) * 4 + h, ss); if (DRY) asm volatile("" :: "v"(ss)); }
        LBAR();
    }
#undef Gg
#undef Vld
}

constexpr int A_KS = 144;
constexpr int A_KT = 0, A_VT = 256 * A_KS, A_END = 2 * 256 * A_KS, A_STG = A_END;
#ifndef SWA_OSTG
#define SWA_OSTG 1
#endif
__device__ __forceinline__ void swa_phase(Frame& F, const bf16* E, const float* sinks, bf16* OAB) {
    int w = F.wave; asm volatile("" : "+s"(w)); const int lane = hw_lane(), tid = w * 64 + lane, g = lane >> 4, r16 = lane & 15, q4 = r16 >> 2, p4 = r16 & 3;
    LAS unsigned char* const lds = F.lds;
    const int hr = w >> 1, hf = w & 1;
    constexpr float LOG2E = 1.4426950408889634f;
    for (int unit = F.vcu; unit < 1024; unit += F.G) {
        const int b = unit >> 7, nb = (unit >> 1) & 63, gk = unit & 1, hq = 4 * gk + hr;
        const size_t row0 = (size_t)b * SEQ + (size_t)nb * 128;
        LBAR();
#pragma unroll
        for (int i = 0; i < 4; ++i) { const int idx = i * 512 + tid, kr = idx >> 3, c = idx & 7; const bool valid = (nb > 0) || (kr >= 128);
            v4u kv = (v4u){0u, 0u, 0u, 0u}, vv = (v4u){0u, 0u, 0u, 0u};
            if (valid) { const bf16* src = E + (row0 + kr - 128) * EVEN_IN + gk * 64 + c * 8; kv = *(const v4u*)(src + 2560); vv = *(const v4u*)(src + 2688); }
            *(LAS v4u*)(lds + A_KT + kr * A_KS + c * 16) = kv; *(LAS v4u*)(lds + A_VT + kr * A_KS + c * 16) = vv; }
        LBAR();
        const float sk = sinks[hq] * LOG2E;
        const bf16* Qb = E + (row0 + 64 * hf + r16) * EVEN_IN + 2048 + hq * 64 + 8 * g;
        bf16x8 qf[2], qn[2]; v2u o2p[4];
#pragma unroll
        for (int ks = 0; ks < 2; ++ks) { qf[ks] = *(const bf16x8*)(Qb + 32 * ks); qn[ks] = *(const bf16x8*)(Qb + (size_t)16 * EVEN_IN + 32 * ks); }
#pragma unroll
        for (int dt = 0; dt < 4; ++dt) o2p[dt] = (v2u){0u, 0u};
        for (int qt = 0; qt < 4; ++qt) {
            const int qi = 64 * hf + 16 * qt + r16, ft = (4 * hf + qt) & ~1;
            if (qt > 0) {
#pragma unroll
                for (int dt = 0; dt < 4; ++dt) { if (SWA_OSTG) *(LAS v2u*)(lds + A_STG + w * 2304 + r16 * 144 + (16 * dt + 4 * g) * 2) = o2p[dt]; else *(v2u*)(OAB + (row0 + qi - 16) * D + 512 + hq * 64 + 16 * dt + 4 * g) = o2p[dt]; }
                if (SWA_OSTG) {
#pragma unroll
                    for (int i = 0; i < 2; ++i) { const v4u o4 = *(const LAS v4u*)(lds + A_STG + w * 2304 + (8 * i + (lane >> 3)) * 144 + (lane & 7) * 16);
                        *(v4u*)(OAB + (row0 + 64 * hf + 16 * (qt - 1) + 8 * i + (lane >> 3)) * D + 512 + hq * 64 + (lane & 7) * 8) = o4; } } }
            bf16x8 q2[2] = {qn[0], qn[1]};
            if (qt + 2 < 4) {
#pragma unroll
                for (int ks = 0; ks < 2; ++ks) q2[ks] = *(const bf16x8*)(Qb + (size_t)(16 * (qt + 2)) * EVEN_IN + 32 * ks); }
            f32x4 st[10]; float mx = sk;
            { bf16x8 ka[2][10];
#pragma unroll
              for (int ks = 0; ks < 2; ++ks)
#pragma unroll
                  for (int j = 0; j < 10; ++j) ka[ks][j] = *(const LAS bf16x8*)(lds + A_KT + (16 * (ft + j) + r16) * A_KS + (32 * ks + 8 * g) * 2);
              __builtin_amdgcn_sched_barrier(0);
#pragma unroll
              for (int j = 0; j < 10; ++j) st[j] = MFMA16(ka[0][j], qf[0], ((f32x4){0.f, 0.f, 0.f, 0.f}));
#pragma unroll
              for (int j = 0; j < 10; ++j) st[j] = MFMA16(ka[1][j], qf[1], st[j]);
              __builtin_amdgcn_sched_barrier(0); }
            {
              const int tq = 4 * hf + qt;
#pragma unroll
              for (int j = 0; j < 10; ++j) { const int T = ft + j;
                  if (T > tq && T < tq + 8 && (nb > 0 || T >= 8)) {
#pragma unroll
                      for (int r = 0; r < 4; ++r) { const float s2 = st[j][r] * (0.125f * LOG2E); st[j][r] = s2; mx = fmaxf(mx, s2); }
                  } else if (T == tq || T == tq + 8) {
#pragma unroll
                      for (int r = 0; r < 4; ++r) { const int kj = 16 * T + 4 * g + r; const bool valid = (kj > qi) && (kj <= qi + 128) && ((nb > 0) || (kj >= 128));
                          const float s2 = valid ? st[j][r] * (0.125f * LOG2E) : -__builtin_inff(); st[j][r] = s2; mx = fmaxf(mx, s2); }
                  } else {
#pragma unroll
                      for (int r = 0; r < 4; ++r) st[j][r] = -__builtin_inff();
                  } } }
            mx = fmaxf(mx, __shfl_xor(mx, 16)); mx = fmaxf(mx, __shfl_xor(mx, 32));
            float sum = 0.f;
#pragma unroll
            for (int j = 0; j < 10; ++j)
#pragma unroll
                for (int r = 0; r < 4; ++r) { const float p = __builtin_amdgcn_exp2f(st[j][r] - mx); st[j][r] = p; sum += p; }
            sum += __shfl_xor(sum, 16); sum += __shfl_xor(sum, 32);
            const float inv = 1.0f / (sum + __builtin_amdgcn_exp2f(sk - mx));
            f32x4 o[4];
#pragma unroll
            for (int dt = 0; dt < 4; ++dt) o[dt] = (f32x4){0.f, 0.f, 0.f, 0.f};
            { bf16x8 va[2][4];
#pragma unroll
              for (int dt = 0; dt < 4; ++dt) { const LAS unsigned char* p = lds + A_VT + (16 * ft + 4 * g + q4) * A_KS + (16 * dt + 4 * p4) * 2; va[0][dt] = trpair(p, p + 16 * A_KS); }
#pragma unroll
              for (int sp = 0; sp < 5; ++sp) { const bf16x8 bfr = pack_acc2(st[2 * sp], st[2 * sp + 1]);
                  if (sp + 1 < 5) {
#pragma unroll
                      for (int dt = 0; dt < 4; ++dt) { const LAS unsigned char* p = lds + A_VT + (16 * (ft + 2 * (sp + 1)) + 4 * g + q4) * A_KS + (16 * dt + 4 * p4) * 2; va[(sp + 1) & 1][dt] = trpair(p, p + 16 * A_KS); } }
                  __builtin_amdgcn_sched_barrier(0);
#pragma unroll
                  for (int dt = 0; dt < 4; ++dt) o[dt] = MFMA16(va[sp & 1][dt], bfr, o[dt]);
                  __builtin_amdgcn_sched_barrier(0); } }
#pragma unroll
            for (int dt = 0; dt < 4; ++dt) { o2p[dt].x = cvtpk(o[dt][0] * inv, o[dt][1] * inv); o2p[dt].y = cvtpk(o[dt][2] * inv, o[dt][3] * inv); }
#pragma unroll
            for (int ks = 0; ks < 2; ++ks) { qf[ks] = qn[ks]; qn[ks] = q2[ks]; }
        }
#pragma unroll
        for (int dt = 0; dt < 4; ++dt) { if (SWA_OSTG) *(LAS v2u*)(lds + A_STG + w * 2304 + r16 * 144 + (16 * dt + 4 * g) * 2) = o2p[dt]; else *(v2u*)(OAB + (row0 + 64 * hf + 48 + r16) * D + 512 + hq * 64 + 16 * dt + 4 * g) = o2p[dt]; }
        if (SWA_OSTG) {
#pragma unroll
            for (int i = 0; i < 2; ++i) { const v4u o4 = *(const LAS v4u*)(lds + A_STG + w * 2304 + (8 * i + (lane >> 3)) * 144 + (lane & 7) * 16);
                *(v4u*)(OAB + (row0 + 64 * hf + 48 + 8 * i + (lane >> 3)) * D + 512 + hq * 64 + (lane & 7) * 8) = o4; } }
    }
    LBAR();
}

#ifndef PROBE_HBD
#define PROBE_HBD 0
#endif
#ifndef PROBE_HBV
#define PROBE_HBV 1
#endif
#ifndef HG_OSTG
#define HG_OSTG 1
#endif
constexpr int H_S = 272;
constexpr int H_RF = 0, H_RQ = 16384, H_VT = 32768, H_QS = H_VT + 64 * H_S, H_KS = H_QS + 64 * H_S, H_KD = H_KS + 64 * H_S, H_ST = H_KD + 64 * H_S, H_TP = H_ST + 128 * H_S, H_DEC = H_TP + 4096, H_SSX = H_DEC + 512, H_END = H_SSX + 512;
static_assert(H_END <= LDSCTL_OFF, "HGRN2 LDS map");
template <bool PASSB, int HV = 0>
__device__ __forceinline__ void hgrn_pass(Frame& F, const bf16* E, const float* hgrn_lb, const float* og, float* SEGL, float* SEGD, bf16* OAB) {
    int w = F.wave; asm volatile("" : "+s"(w)); const int lane = hw_lane(), tid = w * 64 + lane, g = lane >> 4, r16 = lane & 15, q4 = r16 >> 2, p4 = r16 & 3;
    const int ct = w & 3, vh = w >> 2, kp = w & 3;
    LAS unsigned char* const lds = F.lds;
    for (int unit = F.vcu; unit < 256; unit += F.G) {
        const int bh = unit >> 3, seg = unit & 7, b = bh >> 2, h = bh & 3;
        const float lbA = fsig(hgrn_lb[h * 128 + 2 * lane] - hgrn_lb[512 + h * 128 + 2 * lane]), lbB = fsig(hgrn_lb[h * 128 + 2 * lane + 1] - hgrn_lb[512 + h * 128 + 2 * lane + 1]);
        f32x4 ggv[4];
#pragma unroll
        for (int vt = 0; vt < 4; ++vt) ggv[vt] = PASSB ? *(const f32x4*)(og + 64 * vh + 16 * vt + 4 * g) : (f32x4){0.f, 0.f, 0.f, 0.f};
        f32x4 Sacc[2][4];
#pragma unroll
        for (int kt = 0; kt < 2; ++kt)
#pragma unroll
            for (int vt = 0; vt < 4; ++vt) Sacc[kt][vt] = (f32x4){0.f, 0.f, 0.f, 0.f};
        if (PASSB) {
            for (int j = 0; j < seg; ++j) { const float* Lj = SEGL + (size_t)(bh * 8 + j) * 512 * 32 + tid * 4;     const float* Dj = SEGD + (size_t)(bh * 8 + j) * 128 + 32 * kp + 4 * g;
#pragma unroll
                for (int kt = 0; kt < 2; ++kt) { const f32x4 dl = *(const f32x4*)(Dj + 16 * kt); f32x4 dd;
#pragma unroll
                    for (int r = 0; r < 4; ++r) dd[r] = __builtin_amdgcn_exp2f(dl[r]);
#pragma unroll
                    for (int vt = 0; vt < 4; ++vt) Sacc[kt][vt] = Sacc[kt][vt] * dd + *(const f32x4*)(Lj + (kt * 4 + vt) * 2048); } }
        }
        float ldA = 0.f, ldB = 0.f;
        const size_t rowbase = (size_t)b * SEQ + (size_t)seg * 1024;
        const bf16* Eld = E + (rowbase + (tid >> 4)) * EVEN_IN + h * 128 + (tid & 15) * 8;
        v4u Xq[2], Xf[2], Xv[2]; v2u o2p[4];
#pragma unroll
        for (int vt = 0; vt < 4; ++vt) o2p[vt] = (v2u){0u, 0u};
#pragma unroll
        for (int i = 0; i < 2; ++i) { const bf16* s = Eld + (size_t)(32 * i) * EVEN_IN; if (PASSB) Xq[i] = *(const v4u*)s; Xf[i] = *(const v4u*)(s + 512); Xv[i] = *(const v4u*)(s + 1024); }
        for (int n = 0; n < 16; ++n) {
            const size_t t0 = rowbase + (size_t)n * 64;
            LBAR();
#pragma unroll
            for (int i = 0; i < 2; ++i) { const int row = (tid >> 4) + 32 * i, c = tid & 15;
                if (PASSB) *(LAS v4u*)(lds + H_RQ + row * 256 + c * 16) = Xq[i];
                *(LAS v4u*)(lds + H_RF + row * 256 + c * 16) = Xf[i]; *(LAS v4u*)(lds + H_VT + row * H_S + c * 16) = Xv[i]; }
            if (PASSB) {
#pragma unroll
                for (int kt = 0; kt < 2; ++kt)
#pragma unroll
                    for (int vt = 0; vt < 4; ++vt) { v2u s2; s2.x = cvtpk(Sacc[kt][vt][0], Sacc[kt][vt][1]); s2.y = cvtpk(Sacc[kt][vt][2], Sacc[kt][vt][3]);
                        *(LAS v2u*)(lds + H_ST + (64 * vh + 16 * vt + r16) * H_S + (32 * kp + 16 * kt + 4 * g) * 2) = s2; }
            }
            LBAR();
            if (PASSB) {
                if (n > 0) {
#pragma unroll
                    for (int vt = 0; vt < 4; ++vt) { if (HG_OSTG) *(LAS v2u*)(lds + H_QS + w * 2304 + r16 * 144 + (16 * vt + 4 * g) * 2) = o2p[vt]; else *(v2u*)(OAB + (t0 - 64 + 16 * ct + r16) * D + h * 128 + 64 * vh + 16 * vt + 4 * g) = o2p[vt]; }
                    if (HG_OSTG) {
#pragma unroll
                        for (int i = 0; i < 2; ++i) { const v4u o4 = *(const LAS v4u*)(lds + H_QS + w * 2304 + (8 * i + (lane >> 3)) * 144 + (lane & 7) * 16);
                            if (HV == 0) *(v4u*)(OAB + (t0 - 64 + 16 * ct + 8 * i + (lane >> 3)) * D + h * 128 + 64 * vh + (lane & 7) * 8) = o4; else asm volatile("" :: "v"(o4.x), "v"(o4.y), "v"(o4.z), "v"(o4.w)); } } }
            }
            if (n + 1 < 16 && HV < 2) {
#pragma unroll
                for (int i = 0; i < 2; ++i) { const bf16* s = Eld + (size_t)((n + 1) * 64 + 32 * i) * EVEN_IN; if (PASSB) Xq[i] = *(const v4u*)s; Xf[i] = *(const v4u*)(s + 512); Xv[i] = *(const v4u*)(s + 1024); }
            }
            v2u gav[4];
            if (PASSB) {
#pragma unroll
                for (int vt = 0; vt < 4; ++vt) gav[vt] = HV >= 2 ? o2p[vt] : *(const v2u*)(E + (t0 + 16 * ct + r16) * EVEN_IN + 1536 + h * 128 + 64 * vh + 16 * vt + 4 * g);
            }
            float fA[8], fB[8], cA[8], cB[8];
            { float runA = 0.f, runB = 0.f;
#pragma unroll
              for (int r = 0; r < 8; ++r) { const unsigned wv = *(const LAS unsigned*)(lds + H_RF + (8 * w + r) * 256 + lane * 4);
                  const float a = lbA + (1.0f - lbA) * fsg(blo(wv)), bq = lbB + (1.0f - lbB) * fsg(bhi(wv)); fA[r] = a; fB[r] = bq;
                  runA += __builtin_amdgcn_logf(a); runB += __builtin_amdgcn_logf(bq); cA[r] = runA; cB[r] = runB; }
              *(LAS f32x2_t*)(lds + H_TP + (w * 128 + 2 * lane) * 4) = (f32x2_t){runA, runB}; }
            LBAR();
            { float offA = 0.f, offB = 0.f, blA = 0.f, blB = 0.f;
#pragma unroll
              for (int pp = 0; pp < 8; ++pp) { const f32x2_t t = *(const LAS f32x2_t*)(lds + H_TP + (pp * 128 + 2 * lane) * 4); blA += t.x; blB += t.y; if (pp < w) { offA += t.x; offB += t.y; } }
#pragma unroll
              for (int r = 0; r < 8; ++r) { const int t = 8 * w + r; const float bbA = offA + cA[r], bbB = offB + cB[r], kkA = 1.0f - fA[r], kkB = 1.0f - fB[r];
                  *(LAS unsigned*)(lds + H_KD + t * H_S + lane * 4) = cvtpk(kkA * __builtin_amdgcn_exp2f(blA - bbA), kkB * __builtin_amdgcn_exp2f(blB - bbB));
                  if (PASSB) { const unsigned qw = *(const LAS unsigned*)(lds + H_RQ + t * 256 + lane * 4); const float qa = blo(qw), qb = bhi(qw);
                      *(LAS unsigned*)(lds + H_QS + t * H_S + lane * 4) = cvtpk(qa * fsg(qa) * __builtin_amdgcn_exp2f(bbA), qb * fsg(qb) * __builtin_amdgcn_exp2f(bbB));
                      *(LAS unsigned*)(lds + H_KS + t * H_S + lane * 4) = cvtpk(kkA * __builtin_amdgcn_exp2f(-bbA), kkB * __builtin_amdgcn_exp2f(-bbB)); } }
              if (w == 0) { *(LAS f32x2_t*)(lds + H_DEC + 2 * lane * 4) = (f32x2_t){__builtin_amdgcn_exp2f(blA), __builtin_amdgcn_exp2f(blB)}; ldA += blA; ldB += blB; } }
            LBAR();
            f32x4 ot[4];
            if (PASSB) {
                bf16x8 Qf[4];
#pragma unroll
                for (int ks = 0; ks < 4; ++ks) Qf[ks] = *(const LAS bf16x8*)(lds + H_QS + (16 * ct + r16) * H_S + (32 * ks + 8 * g) * 2);
                f32x4 at[4]; bf16x8 ka[2][4];
#pragma unroll
                for (int ks = 0; ks < 4; ++ks) ka[0][ks] = *(const LAS bf16x8*)(lds + H_KS + r16 * H_S + (32 * ks + 8 * g) * 2);
#pragma unroll
                for (int st = 0; st < 4; ++st) { at[st] = (f32x4){0.f, 0.f, 0.f, 0.f};
                    if (st <= ct) {
                        if (st + 1 < 4 && st + 1 <= ct) {
#pragma unroll
                            for (int ks = 0; ks < 4; ++ks) ka[(st + 1) & 1][ks] = *(const LAS bf16x8*)(lds + H_KS + (16 * (st + 1) + r16) * H_S + (32 * ks + 8 * g) * 2); }
                        __builtin_amdgcn_sched_barrier(0);
#pragma unroll
                        for (int ks = 0; ks < 4; ++ks) at[st] = MFMA16(ka[st & 1][ks], Qf[ks], at[st]);
                        __builtin_amdgcn_sched_barrier(0);
#pragma unroll
                        for (int r = 0; r < 4; ++r) if (16 * ct + r16 < 16 * st + 4 * g + r) at[st][r] = 0.f;
                    } }
                bf16x8 sa[2][4];
#pragma unroll
                for (int ks = 0; ks < 4; ++ks) sa[0][ks] = *(const LAS bf16x8*)(lds + H_ST + (64 * vh + r16) * H_S + (32 * ks + 8 * g) * 2);
#pragma unroll
                for (int vt = 0; vt < 4; ++vt) { ot[vt] = (f32x4){0.f, 0.f, 0.f, 0.f};
                    if (vt + 1 < 4) {
#pragma unroll
                        for (int ks = 0; ks < 4; ++ks) sa[(vt + 1) & 1][ks] = *(const LAS bf16x8*)(lds + H_ST + (64 * vh + 16 * (vt + 1) + r16) * H_S + (32 * ks + 8 * g) * 2); }
                    __builtin_amdgcn_sched_barrier(0);
#pragma unroll
                    for (int ks = 0; ks < 4; ++ks) ot[vt] = MFMA16(sa[vt & 1][ks], Qf[ks], ot[vt]);
                    __builtin_amdgcn_sched_barrier(0); }
#pragma unroll
                for (int sp = 0; sp < 2; ++sp) if (2 * sp <= ct) { const bf16x8 bfr = pack_acc2(at[2 * sp], at[2 * sp + 1]);
#pragma unroll
                    for (int vt = 0; vt < 4; ++vt) { const LAS unsigned char* p = lds + H_VT + (32 * sp + 4 * g + q4) * H_S + (64 * vh + 16 * vt + 4 * p4) * 2; ot[vt] = MFMA16(trpair(p, p + 16 * H_S), bfr, ot[vt]); } }
            }
#pragma unroll
            for (int kt = 0; kt < 2; ++kt) { const f32x4 dd = *(const LAS f32x4*)(lds + H_DEC + (32 * kp + 16 * kt + 4 * g) * 4);
#pragma unroll
                for (int vt = 0; vt < 4; ++vt) Sacc[kt][vt] = Sacc[kt][vt] * dd; }
#pragma unroll
            for (int ss = 0; ss < 2; ++ss) { bf16x8 af[2];
#pragma unroll
                for (int kt = 0; kt < 2; ++kt) { const LAS unsigned char* p = lds + H_KD + (32 * ss + 8 * g + q4) * H_S + (32 * kp + 16 * kt + 4 * p4) * 2; af[kt] = trpair(p, p + 4 * H_S); }
#pragma unroll
                for (int vt = 0; vt < 4; ++vt) { const LAS unsigned char* p = lds + H_VT + (32 * ss + 8 * g + q4) * H_S + (64 * vh + 16 * vt + 4 * p4) * 2; const bf16x8 bv = trpair(p, p + 4 * H_S);
#pragma unroll
                    for (int kt = 0; kt < 2; ++kt) Sacc[kt][vt] = MFMA16(af[kt], bv, Sacc[kt][vt]); } }
            if (PASSB) {
                float ss = 0.f;
#pragma unroll
                for (int vt = 0; vt < 4; ++vt) ss += (ot[vt][0] * ot[vt][0] + ot[vt][1] * ot[vt][1]) + (ot[vt][2] * ot[vt][2] + ot[vt][3] * ot[vt][3]);
                ss += __shfl_xor(ss, 16); ss += __shfl_xor(ss, 32);
                if (g == 0) *(LAS float*)(lds + H_SSX + (vh * 64 + 16 * ct + r16) * 4) = ss;
                LBAR();
                const float tot = *(const LAS float*)(lds + H_SSX + (16 * ct + r16) * 4) + *(const LAS float*)(lds + H_SSX + (64 + 16 * ct + r16) * 4);
                const float rstd = rsqrtf(tot * (1.0f / 128.0f) + EPS);
#pragma unroll
                for (int vt = 0; vt < 4; ++vt) { const f32x4 gg = ggv[vt];
                    const float a0 = blo(gav[vt].x), a1 = bhi(gav[vt].x), a2 = blo(gav[vt].y), a3 = bhi(gav[vt].y);
                    v2u o2; o2.x = cvtpk(ot[vt][0] * rstd * gg[0] * a0 * fsg(a0), ot[vt][1] * rstd * gg[1] * a1 * fsg(a1)); o2.y = cvtpk(ot[vt][2] * rstd * gg[2] * a2 * fsg(a2), ot[vt][3] * rstd * gg[3] * a3 * fsg(a3));
                    o2p[vt] = o2; }
            }
        }
        if (PASSB) {
#pragma unroll
            for (int vt = 0; vt < 4; ++vt) { if (!HG_OSTG) *(v2u*)(OAB + (rowbase + 15 * 64 + 16 * ct + r16) * D + h * 128 + 64 * vh + 16 * vt + 4 * g) = o2p[vt]; }
            if (HG_OSTG) { LBAR();
#pragma unroll
                for (int vt = 0; vt < 4; ++vt) *(LAS v2u*)(lds + H_QS + w * 2304 + r16 * 144 + (16 * vt + 4 * g) * 2) = o2p[vt];
#pragma unroll
                for (int i = 0; i < 2; ++i) { const v4u o4 = *(const LAS v4u*)(lds + H_QS + w * 2304 + (8 * i + (lane >> 3)) * 144 + (lane & 7) * 16);
                    if (HV == 0) *(v4u*)(OAB + (rowbase + 15 * 64 + 16 * ct + 8 * i + (lane >> 3)) * D + h * 128 + 64 * vh + (lane & 7) * 8) = o4; else asm volatile("" :: "v"(o4.x), "v"(o4.y), "v"(o4.z), "v"(o4.w)); } }
        }
        if (!PASSB) {
            float* Lo = SEGL + (size_t)unit * 512 * 32 + tid * 4;
#pragma unroll
            for (int kt = 0; kt < 2; ++kt)
#pragma unroll
                for (int vt = 0; vt < 4; ++vt) *(f32x4*)(Lo + (kt * 4 + vt) * 2048) = Sacc[kt][vt];
            if (w == 0) *(f32x2_t*)(SEGD + (size_t)unit * 128 + 2 * lane) = (f32x2_t){ldA, ldB};
        }
        LBAR();
    }
}

struct Args { const float* in[18]; float* out; unsigned char* ws; };
#ifndef GEMM_STAGGER
#define GEMM_STAGGER 0
#endif
#ifndef PROBE_GSEL
#define PROBE_GSEL 0
#endif
#ifndef PROBE_GEMM2
#define PROBE_GEMM2 0
#endif
#ifndef PROBE_P0
#define PROBE_P0 0
#endif
#ifndef PROBE_HA
#define PROBE_HA 0
#endif
#ifndef PROBE_SWA
#define PROBE_SWA 0
#endif
#ifndef PROBE_HB
#define PROBE_HB 0
#endif
#ifndef PROBE_MIX2
#define PROBE_MIX2 0
#endif
#ifndef PROBE_ATT2
#define PROBE_ATT2 0
#endif
#ifndef PROBE_RET2
#define PROBE_RET2 0
#endif
#ifndef PROBE_THIN2
#define PROBE_THIN2 0
#endif
#define THIN_DUMMY(NORM2, CONVP, hin, Y, gA, gB, psrc) do { if (PROBE_THIN2) { thin_pass<NORM2, true, CONVP>(F, hin, Y, gA, 0.5f, (float*)BIGP(384 * MiB), gB, (bf16*)BIGP(640 * MiB), psrc, (bf16*)BIGP(704 * MiB)); } } while (0)
__device__ __forceinline__ unsigned long long karg(int idx) {
    const __attribute__((address_space(4))) unsigned char* kp = (const __attribute__((address_space(4))) unsigned char*)__builtin_amdgcn_kernarg_segment_ptr();
    asm volatile("" : "+s"(kp));
    return *(const __attribute__((address_space(4))) unsigned long long*)(kp + 8 * idx);
}
#define IN_F(i) ((const float*)(GAS const float*)karg(i))
#define WSP() ((unsigned char*)(GAS unsigned char*)karg(19))
#define OUTP() ((float*)(GAS float*)karg(18))
#define SW_WORD(i) (((volatile LAS unsigned*)(F.lds + MISC_OFF)) + 32 + (i))
__global__ void __launch_bounds__(NWAVES * 64, 2) mk_fwd(Args args) {
    extern __shared__ __attribute__((aligned(16))) unsigned char lds[];
    Frame F;
    F.lds = (LAS unsigned char*)lds;
    F.wave = __builtin_amdgcn_readfirstlane(threadIdx.x >> 6);
    F.G = gridDim.x; { const int bx = blockIdx.x; F.vcu = (F.G % 8 == 0) ? (bx % 8) * (F.G / 8) + bx / 8 : bx; }
    for (int u = threadIdx.x; u < (LDS_BYTES - LDSCTL_OFF) / 4; u += NWAVES * 64) ((LAS unsigned*)(F.lds + LDSCTL_OFF))[u] = 0u;
    __syncthreads();
    (void)xcd_barrier_post((unsigned*)(WSP() + WS_CTL) + CW_BAR, (volatile LAS unsigned*)(F.lds + MISC_OFF) + 8);
#if PROBE_SKEW
    { int bxk_ = blockIdx.x; asm volatile("" : "+s"(bxk_)); if (bxk_ == 0 && F.wave == 0) ((unsigned*)(WSP() + WS_CTL + 768 * 1024))[60] = (unsigned)__builtin_amdgcn_s_memrealtime(); }
#endif
#if PROBE_SKEW
#define GRID_BAR() do { XcdBarrier bb_; bb_.bar = (unsigned*)(WSP() + WS_CTL) + CW_BAR; bb_.x = xb_xcc_id(); bb_.wv = F.wave; bb_.st = (volatile LAS unsigned*)(F.lds + MISC_OFF) + 8; \
        int bxs_ = blockIdx.x; asm volatile("" : "+s"(bxs_)); volatile LAS unsigned* cw_ = SW_WORD(4); const unsigned bi_ = *cw_; bb_.ts = (unsigned*)(WSP() + WS_CTL + 512 * 1024) + bi_ * 256 + bxs_; xcd_barrier(bb_); if (F.wave == 0) { *cw_ = bi_ + 1; if (bxs_ == 0) ((unsigned*)(WSP() + WS_CTL + 768 * 1024))[bi_] = (unsigned)__builtin_amdgcn_s_memrealtime(); } } while (0)
#else
#define GRID_BAR() do { XcdBarrier bb_; bb_.bar = (unsigned*)(WSP() + WS_CTL) + CW_BAR; bb_.x = xb_xcc_id(); bb_.wv = F.wave; bb_.st = (volatile LAS unsigned*)(F.lds + MISC_OFF) + 8; xcd_barrier(bb_); } while (0)
#endif
#define RING ((PG8_LAS unsigned char*)(F.lds + RING_OFF))
#define HBP ((bf16*)(WSP() + WS_YN))
#define YP ((bf16*)OUTP())
#define RSP ((float*)(WSP() + WS_RS))
#define BIGP(off) (WSP() + WS_BIG + (off))
#define GSEL_ 0
#define GEMM_PHASE(EPI, A_, B_, N_, K_, ...) do { int bx_ = blockIdx.x, G_ = F.G; asm volatile("" : "+s"(bx_), "+s"(G_));     \
        pg8::Gemm gm_{(const bf16*)(A_), (const bf16*)(B_), M, (N_), (K_)}; pg8::StaticOrder S_; S_.init(M, (N_), G_, bx_); S_.wave_id = F.wave; pg8::EPI Ep_{__VA_ARGS__}; \
        if (GEMM_STAGGER > 0 && ((bx_ >> 5) & 1)) { _Pragma("unroll") for (int d_ = 0; d_ < GEMM_STAGGER; ++d_) __builtin_amdgcn_s_sleep(127); }     \
        pg8::gemm_phase<pg8::EPI, pg8::StaticOrder, true, true>(RING, gm_, S_, Ep_); \
        if (PROBE_GEMM2 || (PROBE_GSEL && PROBE_GSEL == GSEL_)) { __syncthreads(); pg8::gemm_phase<pg8::EPI, pg8::StaticOrder, true, true>(RING, gm_, S_, Ep_); } } while (0)
#ifndef FFN_FP8
#define FFN_FP8 1
#endif
#define FP8_SH 5
#define FP8_ASH 2
#define FP8_WSH 6
#ifndef FFN_FP8_OUT
#define FFN_FP8_OUT 1
#endif
#ifndef FFN1_OUT_FP8
#define FFN1_OUT_FP8 1
#endif
#ifndef FFN_FP8_P0
#define FFN_FP8_P0 1
#endif
#define W8BP (FFN_FP8_P0 ? (unsigned char*)(WSP() + WS_WB + (size_t)(DEPTH - 1) * W_LAYER + WO_2OUT) : (unsigned char*)OUTP() + 200 * MiB)
static_assert(FP8_SH == 5 && FP8_ASH == 2, "EpiSwiGLU8o is EpiSwiGLUx<5, 2>");
#ifndef FFN_FP8_N
#define FFN_FP8_N 1
#endif
#define GEMM_PHASE8(EPI, A_, B_, N_, KB_, ...) do { int bx_ = blockIdx.x, G_ = F.G; asm volatile("" : "+s"(bx_), "+s"(G_)); \
        pg8::Gemm gm_{(const bf16*)(A_), (const bf16*)(B_), M, (N_), (KB_) / 2}; pg8::StaticOrder S_; S_.init(M, (N_), G_, bx_); S_.wave_id = F.wave; pg8::EPI Ep_{__VA_ARGS__}; \
        pg8::gemm_phase<pg8::EPI, pg8::StaticOrder, true, true, false, FP8_SH>(RING, gm_, S_, Ep_); } while (0)
#define HB8P ((unsigned char*)OUTP() + 128 * MiB)
#define W8P (FFN_FP8_P0 ? (unsigned char*)(WSP() + WS_WB + (size_t)(DEPTH - 1) * W_LAYER + WO_2IN) : (unsigned char*)OUTP() + 192 * MiB)

    for (int rep_ = 0; rep_ < (PROBE_P0 ? 2 : 1); ++rep_) {
        LAS float* scr = (LAS float*)(F.lds + RING_OFF + F.wave * 16384);
        int cb_ = 0;
#if P0_PAIR
        for (int l = 0; l < DEPTH; ++l) { unsigned char* wl = WSP() + WS_WB + l * W_LAYER; const float* ng = IN_F(3) + (size_t)l * 7 * D;
            conv_pair<1, 0>(F, IN_F(4) + (size_t)l * D * 2 * FF, D, 2 * FF, (bf16*)(wl + WO_1IN), ng, IN_F(5) + (size_t)l * FF * D, FF, D, (bf16*)(wl + WO_1OUT), nullptr, scr, cb_);
            conv_pair<1, 0>(F, IN_F(6) + (size_t)l * D * 2 * FF, D, 2 * FF, (bf16*)(wl + WO_2IN), ng + 4 * D, IN_F(7) + (size_t)l * FF * D, FF, D, (bf16*)(wl + WO_2OUT), nullptr, scr, cb_);
            conv_pair<0, 0>(F, IN_F(8) + (size_t)l * PLE * D, PLE, D, (bf16*)(wl + WO_PROJ), nullptr, IN_F(9) + (size_t)l * D * D, D, D, (bf16*)(wl + WO_GATE), nullptr, scr, cb_); }
        conv_pair<2, 0>(F, IN_F(10), D, EVEN_IN, (bf16*)(WSP() + WS_WEVIN), IN_F(3) + 2 * D, IN_F(11), D, D, (bf16*)(WSP() + WS_WEVOUT), nullptr, scr, cb_);
        conv_pair<0, 0>(F, IN_F(15), D, ODD_IN, (bf16*)(WSP() + WS_WODIN), IN_F(3) + 9 * D, IN_F(16), 2048, D, (bf16*)(WSP() + WS_WODOUT), nullptr, scr, cb_);
#else
        for (int l = 0; l < DEPTH; ++l) { unsigned char* wl = WSP() + WS_WB + l * W_LAYER; const float* ng = IN_F(3) + (size_t)l * 7 * D;
            conv_matrix<1>(F, IN_F(4) + (size_t)l * D * 2 * FF, D, 2 * FF, (bf16*)(wl + WO_1IN), scr, cb_, ng);
            if (FFN_FP8 && FFN1_OUT_FP8 && l == DEPTH - 1) conv_matrix_fp8<0>(F, IN_F(5) + (size_t)l * FF * D, FF, D, (unsigned char*)(wl + WO_1OUT), scr, nullptr, (float)(1 << FP8_WSH), &cb_);
            else conv_matrix<0>(F, IN_F(5) + (size_t)l * FF * D, FF, D, (bf16*)(wl + WO_1OUT), scr, cb_);
            if (FFN_FP8 && FFN_FP8_P0 && l == DEPTH - 1) {
                conv_matrix_fp8<1>(F, IN_F(6) + (size_t)l * D * 2 * FF, D, 2 * FF, (unsigned char*)(wl + WO_2IN), scr, ng + 4 * D, (float)(1 << FP8_SH), &cb_);
                if (FFN_FP8_OUT) conv_matrix_fp8<0>(F, IN_F(7) + (size_t)l * FF * D, FF, D, (unsigned char*)(wl + WO_2OUT), scr, nullptr, (float)(1 << FP8_WSH), &cb_);
                else conv_matrix<0>(F, IN_F(7) + (size_t)l * FF * D, FF, D, (bf16*)(wl + WO_2OUT), scr, cb_);
            } else {
            conv_matrix<1>(F, IN_F(6) + (size_t)l * D * 2 * FF, D, 2 * FF, (bf16*)(wl + WO_2IN), scr, cb_, ng + 4 * D);
            conv_matrix<0>(F, IN_F(7) + (size_t)l * FF * D, FF, D, (bf16*)(wl + WO_2OUT), scr, cb_); }
            conv_matrix<0>(F, IN_F(8) + (size_t)l * PLE * D, PLE, D, (bf16*)(wl + WO_PROJ), scr, cb_);
            conv_matrix<0>(F, IN_F(9) + (size_t)l * D * D, D, D, (bf16*)(wl + WO_GATE), scr, cb_); }
        conv_matrix<2>(F, IN_F(10), D, EVEN_IN, (bf16*)(WSP() + WS_WEVIN), scr, cb_, IN_F(3) + 2 * D);
        conv_matrix<0>(F, IN_F(11), D, D, (bf16*)(WSP() + WS_WEVOUT), scr, cb_);
        conv_matrix<0>(F, IN_F(15), D, ODD_IN, (bf16*)(WSP() + WS_WODIN), scr, cb_, IN_F(3) + 9 * D);
        conv_matrix<0>(F, IN_F(16), 2048, D, (bf16*)(WSP() + WS_WODOUT), scr, cb_);
#endif
#if PROBE_SKEW == 7
        if (F.wave == 0) { int bxq_ = blockIdx.x; asm volatile("" : "+s"(bxq_)); if (bxq_ == PROBE_P0WG) ((unsigned*)(WSP() + WS_CTL + 768 * 1024))[61] = (unsigned)__builtin_amdgcn_s_memrealtime(); }
#endif
        init_rows(F, IN_F(0), HBP, RSP);
#if PROBE_SKEW == 7
        if (F.wave == 0) { int bxq_ = blockIdx.x; asm volatile("" : "+s"(bxq_)); if (bxq_ == PROBE_P0WG) ((unsigned*)(WSP() + WS_CTL + 768 * 1024))[62] = (unsigned)__builtin_amdgcn_s_memrealtime(); }
#endif
        GRID_BAR();
    }
    for (int l = 0; l < DEPTH; ++l) {
#define NG(k) (IN_F(3) + ((size_t)l * 7 + (k)) * D)
#define WL(off) (WSP() + WS_WB + (size_t)l * W_LAYER + (off))
#undef GSEL_
#define GSEL_ 1
        if (FFN_FP8 && FFN_FP8_N >= 2 && DEPTH == 2 && l == DEPTH - 1) GEMM_PHASE8(EpiSwiGLUx<FP8_SH>, HB8P, W8P, 2 * FF, D, (bf16*)BIGP(BIG_ACT), FF);
        else if (FFN_FP8 && FFN1_OUT_FP8 && l == DEPTH - 1) GEMM_PHASE(EpiSwiGLU0o, HBP, WL(WO_1IN), 2 * FF, D, (bf16*)BIGP(BIG_ACT), FF);
        else GEMM_PHASE(EpiSwiGLU, HBP, WL(WO_1IN), 2 * FF, D, (bf16*)BIGP(BIG_ACT), FF);
        GRID_BAR();
#undef GSEL_
#define GSEL_ 2
        if (FFN_FP8 && FFN1_OUT_FP8 && l == DEPTH - 1) GEMM_PHASE8(EpiStoreS<FP8_ASH + FP8_WSH>, BIGP(BIG_ACT), WL(WO_1OUT), D, FF, YP, D);
        else GEMM_PHASE(EpiStore, BIGP(BIG_ACT), WL(WO_1OUT), D, FF, YP, D);
        GRID_BAR();
        if (PROBE_THIN2) { thin_pass<false, false>(F, HBP, YP, NG(1), 0.5f, RSP, nullptr, nullptr, nullptr, (bf16*)BIGP(640 * MiB)); }
        thin_pass<false, false>(F, HBP, YP, NG(1), 0.5f, RSP, nullptr, nullptr, nullptr); GRID_BAR();
        if (l == 0) {
#undef GSEL_
#define GSEL_ 3
            GEMM_PHASE(EpiEvenIn, HBP, WSP() + WS_WEVIN, EVEN_IN, D, (bf16*)BIGP(BIG_E), (const int*)IN_F(2)); GRID_BAR();
            for (int rep_ = 0; rep_ < (PROBE_HA ? PROBE_HA : 1); ++rep_)
            hgrn_pass<false>(F, (const bf16*)BIGP(BIG_E), IN_F(12), IN_F(13), (float*)BIGP(BIG_SEGL), (float*)BIGP(BIG_SEGD), (bf16*)BIGP(BIG_OAB));
            for (int rep_ = 0; rep_ < (PROBE_SWA ? PROBE_SWA : 1); ++rep_)
            swa_phase(F, (const bf16*)BIGP(BIG_E), IN_F(14), (bf16*)BIGP(BIG_OAB));
            GRID_BAR();
            for (int rep_ = 0; rep_ < (PROBE_HB ? PROBE_HB : 1); ++rep_)
            for (int rep_ = 0; rep_ < PROBE_HBD; ++rep_) { hgrn_pass<true, (PROBE_HBV > 0 ? PROBE_HBV : 1)>(F, (const bf16*)BIGP(BIG_E), IN_F(12), IN_F(13), (float*)BIGP(BIG_SEGL), (float*)BIGP(BIG_SEGD), (bf16*)BIGP(BIG_OAB)); }
            hgrn_pass<true>(F, (const bf16*)BIGP(BIG_E), IN_F(12), IN_F(13), (float*)BIGP(BIG_SEGL), (float*)BIGP(BIG_SEGD), (bf16*)BIGP(BIG_OAB));
            GRID_BAR();
#undef GSEL_
#define GSEL_ 4
            GEMM_PHASE(EpiStore, BIGP(BIG_OAB), WSP() + WS_WEVOUT, D, D, YP, D); GRID_BAR();
        } else {
#undef GSEL_
#define GSEL_ 3
            GEMM_PHASE(EpiOddIn, HBP, WSP() + WS_WODIN, ODD_IN, D, (bf16*)BIGP(BIG_Q), (bf16*)BIGP(BIG_K), (bf16*)BIGP(BIG_V), (bf16*)BIGP(BIG_G), (const int*)IN_F(2), IN_F(17)); GRID_BAR();
            ret_att_phase(F, (const bf16*)BIGP(BIG_Q), (const bf16*)BIGP(BIG_K), (bf16x8*)OUTP(), (bf16*)OUTP() + 32 * MiB); GRID_BAR();
            if (PROBE_ATT2) { ret_att_phase(F, (const bf16*)BIGP(BIG_Q), (const bf16*)BIGP(BIG_K), (bf16x8*)OUTP(), (bf16*)OUTP() + 32 * MiB); GRID_BAR(); }
            for (int rep_ = 0; rep_ < PROBE_RET2; ++rep_) { ret_phase<true>(F, (const bf16*)BIGP(BIG_Q), (const bf16*)OUTP() + 32 * MiB, (bf16*)BIGP(BIG_V), (const bf16*)BIGP(BIG_G), (const bf16x8*)OUTP(), (float*)(WSP() + WS_SSQ)); GRID_BAR(); }
            ret_phase<false>(F, (const bf16*)BIGP(BIG_Q), (const bf16*)OUTP() + 32 * MiB, (bf16*)BIGP(BIG_V), (const bf16*)BIGP(BIG_G), (const bf16x8*)OUTP(), (float*)(WSP() + WS_SSQ)); GRID_BAR();
#undef GSEL_
#define GSEL_ 4
            GEMM_PHASE(EpiStoreHS, BIGP(BIG_V), WSP() + WS_WODOUT, D, 2048, YP, D, (const float*)(WSP() + WS_SSQ)); GRID_BAR();
        }
        if (PROBE_THIN2) { thin_pass<false, true>(F, HBP, YP, NG(3), 1.0f, RSP, nullptr, IN_F(1) + (size_t)l * M * PLE, (bf16*)BIGP(BIG_PB), (bf16*)BIGP(640 * MiB)); }
        if (FFN_FP8 && l == DEPTH - 1) { LAS float* scr8 = (LAS float*)(F.lds + RING_OFF + F.wave * 16384);
            if (!FFN_FP8_P0) { conv_matrix_fp8<1>(F, IN_F(6) + (size_t)l * D * 2 * FF, D, 2 * FF, W8P, scr8, NG(4), (float)(1 << FP8_SH));
                if (FFN_FP8_OUT) conv_matrix_fp8<0>(F, IN_F(7) + (size_t)l * FF * D, FF, D, W8BP, scr8, nullptr, (float)(1 << FP8_WSH)); }
            thin_pass<false, true>(F, HBP, YP, NG(3), 1.0f, RSP, nullptr, IN_F(1) + (size_t)l * M * PLE, (bf16*)BIGP(BIG_PB), nullptr, HB8P); }
        else thin_pass<false, true>(F, HBP, YP, NG(3), 1.0f, RSP, nullptr, IN_F(1) + (size_t)l * M * PLE, (bf16*)BIGP(BIG_PB));
        GRID_BAR();
#undef GSEL_
#define GSEL_ 1
        if (FFN_FP8 && l == DEPTH - 1) { if (FFN_FP8_OUT) GEMM_PHASE8(EpiSwiGLU8o, HB8P, W8P, 2 * FF, D, (bf16*)BIGP(BIG_ACT), FF); else GEMM_PHASE8(EpiSwiGLUx<FP8_SH>, HB8P, W8P, 2 * FF, D, (bf16*)BIGP(BIG_ACT), FF); }
        else GEMM_PHASE(EpiSwiGLU, HBP, WL(WO_2IN), 2 * FF, D, (bf16*)BIGP(BIG_ACT), FF);
        GRID_BAR();
#undef GSEL_
#define GSEL_ 2
        if (FFN_FP8 && FFN_FP8_OUT && l == DEPTH - 1) GEMM_PHASE8(EpiStoreS<FP8_ASH + FP8_WSH>, BIGP(BIG_ACT), W8BP, D, FF, YP, D);
        else GEMM_PHASE(EpiStore, BIGP(BIG_ACT), WL(WO_2OUT), D, FF, YP, D);
#undef GSEL_
#define GSEL_ 4
        GEMM_PHASE(EpiStore, BIGP(BIG_PB), WL(WO_PROJ), D, PLE, (bf16*)BIGP(BIG_T), D); GRID_BAR();
        if (PROBE_THIN2) { thin_pass<false, false>(F, HBP, YP, NG(5), 0.5f, RSP, nullptr, nullptr, nullptr, (bf16*)BIGP(640 * MiB)); }
        thin_pass<false, false>(F, HBP, YP, NG(5), 0.5f, RSP, nullptr, nullptr, nullptr); GRID_BAR();
#undef GSEL_
#define GSEL_ 4
        GEMM_PHASE(EpiPleG, HBP, WL(WO_GATE), D, D, (bf16*)BIGP(BIG_Z), (const bf16*)BIGP(BIG_T), RSP); GRID_BAR();
        if (l == 0) {
            if (FFN_FP8 && FFN_FP8_N >= 2 && DEPTH == 2) { LAS float* scr8 = (LAS float*)(F.lds + RING_OFF + F.wave * 16384);
                conv_matrix_fp8<1>(F, IN_F(4) + (size_t)(l + 1) * D * 2 * FF, D, 2 * FF, W8P, scr8, IN_F(3) + ((size_t)(l + 1) * 7 + 0) * D, (float)(1 << FP8_SH));
                thin_pass<false, false>(F, HBP, (const bf16*)BIGP(BIG_Z), NG(6), 1.0f, RSP, nullptr, nullptr, nullptr, nullptr, HB8P); }
            else thin_pass<false, false>(F, HBP, (const bf16*)BIGP(BIG_Z), NG(6), 1.0f, RSP, nullptr, nullptr, nullptr);
            GRID_BAR(); }
        else thin_pass<true, false>(F, HBP, (const bf16*)BIGP(BIG_Z), NG(6), 1.0f, RSP, OUTP(), nullptr, nullptr);
    }
#if PROBE_SKEW
    { GRID_BAR(); int bx_ = blockIdx.x; asm volatile("" : "+s"(bx_)); if (bx_ == 0 && F.wave == 0) {
        const unsigned nb = *SW_WORD(4); const unsigned* TS = (const unsigned*)(WSP() + WS_CTL + 512 * 1024); const int lane = hw_lane(); unsigned total = 0;
        for (unsigned i = 0; i < nb && i < 64; ++i) { if (!((PROBE_SKEW_MASK >> i) & 1ull)) continue;
            const unsigned base = __hip_atomic_load(TS + i * 256, __ATOMIC_RELAXED, __HIP_MEMORY_SCOPE_AGENT);
            int mx = -2147483647, mn = 2147483647, sm = 0;
            for (int k = 0; k < 4; ++k) { const int d = (int)(__hip_atomic_load(TS + i * 256 + lane * 4 + k, __ATOMIC_RELAXED, __HIP_MEMORY_SCOPE_AGENT) - base); mx = d > mx ? d : mx; mn = d < mn ? d : mn; sm += d; }
            int xs[4];
            for (int k = 0; k < 4; ++k) { xs[k] = (int)(__hip_atomic_load(TS + i * 256 + lane * 4 + k, __ATOMIC_RELAXED, __HIP_MEMORY_SCOPE_AGENT) - base); for (int o = 32; o >= 2; o >>= 1) xs[k] += __shfl_xor(xs[k], o); }
            int xm = xs[0]; for (int k = 1; k < 4; ++k) xm = xs[k] > xm ? xs[k] : xm; { const int a = __shfl_xor(xm, 1); xm = a > xm ? a : xm; }
            for (int o = 32; o; o >>= 1) { const int a = __shfl_xor(mx, o), c = __shfl_xor(mn, o); mx = a > mx ? a : mx; mn = c < mn ? c : mn; sm += __shfl_xor(sm, o); }
            if (PROBE_SKEW == 7) { const unsigned* EX = (const unsigned*)(WSP() + WS_CTL + 768 * 1024); if (i == 0) { const unsigned e60 = __hip_atomic_load(EX + 60, __ATOMIC_RELAXED, __HIP_MEMORY_SCOPE_AGENT), e61 = __hip_atomic_load(EX + 61, __ATOMIC_RELAXED, __HIP_MEMORY_SCOPE_AGENT), e62 = __hip_atomic_load(EX + 62, __ATOMIC_RELAXED, __HIP_MEMORY_SCOPE_AGENT);
                total += PROBE_P0SEL == 0 ? e61 - e60 : e62 - e61; } continue; }
            if (PROBE_SKEW == 5) { const unsigned* EX = (const unsigned*)(WSP() + WS_CTL + 768 * 1024); const unsigned e1 = __hip_atomic_load(EX + i, __ATOMIC_RELAXED, __HIP_MEMORY_SCOPE_AGENT), e0 = __hip_atomic_load(EX + (i == 0 ? 60 : i - 1), __ATOMIC_RELAXED, __HIP_MEMORY_SCOPE_AGENT); total += e1 - e0; continue; }
            if (PROBE_SKEW == 4) { const unsigned ex = __hip_atomic_load((const unsigned*)(WSP() + WS_CTL + 768 * 1024) + i, __ATOMIC_RELAXED, __HIP_MEMORY_SCOPE_AGENT); total += (unsigned)((int)(ex - base) - mx); continue; }
            total += PROBE_SKEW == 3 ? (unsigned)(xm / 32 - sm / 256) : PROBE_SKEW == 2 ? (unsigned)(mx - mn) : (unsigned)(mx - sm / 256); }
        const unsigned tk_ = total * PROBE_SKEW_AMP; const unsigned long long t0_ = __builtin_amdgcn_s_memrealtime(); while ((unsigned)(__builtin_amdgcn_s_memrealtime() - t0_) < tk_) __builtin_amdgcn_s_sleep(8); } }
#endif
}

extern "C" void kernel_launch(void* const* d_in, const int* in_sizes, int n_in, void* d_out, int out_size, void* d_ws, size_t ws_size, hipStream_t stream) {
    static int grid = 0;
    if (grid == 0) {
        if (n_in != 18 || in_sizes[0] != M * D || out_size != M * D || ws_size < WS_NEED) { fprintf(stderr, "kernel_launch: unexpected shapes: n_in %d in0 %d out %d ws %zu (need %zu)\n", n_in, n_in > 0 ? in_sizes[0] : -1, out_size, ws_size, (size_t)WS_NEED); grid = -1; return; }
        int dev = 0, cus = 0, per_cu = 0;
        if (hipGetDevice(&dev) != hipSuccess || hipDeviceGetAttribute(&cus, hipDeviceAttributeMultiprocessorCount, dev) != hipSuccess) { grid = -1; return; }
        if (hipFuncSetAttribute((const void*)mk_fwd, hipFuncAttributeMaxDynamicSharedMemorySize, LDS_BYTES) != hipSuccess) { fprintf(stderr, "kernel_launch: hipFuncSetAttribute failed\n"); grid = -1; return; }
        if (hipOccupancyMaxActiveBlocksPerMultiprocessor(&per_cu, (const void*)mk_fwd, NWAVES * 64, LDS_BYTES) != hipSuccess || per_cu < 1) { fprintf(stderr, "kernel_launch: occupancy query reports %d\n", per_cu); }
        (void)hipGetLastError();
        grid = cus;
    }
    if (grid < 0) return;
    if (hipMemsetAsync((char*)d_ws + WS_CTL, 0, CTL_ZERO_BYTES, stream) != hipSuccess) return;
    Args a{};
    for (int i = 0; i < 18; ++i) a.in[i] = (const float*)d_in[i];
    a.out = (float*)d_out; a.ws = (unsigned char*)d_ws;
    hipLaunchKernelGGL(mk_fwd, dim3(grid), dim3(NWAVES * 64), LDS_BYTES, stream, a);
}
```
